# Optimizing an MI355X kernel written in HIP

```python
import jax, jax.numpy as jnp
from jax import lax
import numpy as np

D_MODEL = 1024
BATCH = 16
SEQ = 2048
DEPTH = 4

N_MIXERS = 2
WINDOWS = (128, 512, 2048)
DILATIONS = (1, 4, 16)
N_GROUPS = len(WINDOWS)
N_HEADS = 16
HEAD_DIM = D_MODEL // N_HEADS
ROPE_THETA = 10000.0
POOL_SIZES = (2, 4, 8, 16)
N_POOL_GROUPS = len(POOL_SIZES)
POOL_CH = D_MODEL // N_POOL_GROUPS
D_FF = ((8 * D_MODEL // 3 + 255) // 256) * 256
N_EXPERTS = 8
TOP_K = 2
D_FF_EXPERT = 7 * D_MODEL // 2
MOE_BLOCK = 256
RMS_EPS = 1e-6
MASK_VALUE = -1e30

kernel_name = 'hybrid_dilated_attn_pool_moe_trunk'


def rmsnorm(x, g):
    xf = x.astype(jnp.float32)
    y = xf * lax.rsqrt(jnp.mean(xf * xf, axis=-1, keepdims=True) + RMS_EPS)
    return (y * g.astype(jnp.float32)).astype(x.dtype)


def rope_tables(seq):
    pos = jnp.arange(seq, dtype=jnp.float32)
    inv_freq = ROPE_THETA ** (-jnp.arange(0, HEAD_DIM, 2, dtype=jnp.float32) / HEAD_DIM)
    ang = pos[:, None] * inv_freq[None, :]
    ang = jnp.concatenate([ang, ang], axis=-1)
    return jnp.cos(ang), jnp.sin(ang)


def apply_rope(t, cos, sin):
    half = HEAD_DIM // 2
    rot = jnp.concatenate([-t[..., half:], t[..., :half]], axis=-1)
    return t * cos[None, :, None, :] + rot * sin[None, :, None, :]


def dilated_window_attention(q, k, v, dilation, sub_window):
    B, S, H, Dh = q.shape
    d, W = dilation, sub_window
    L = S // d
    nb = -(-L // W)
    Lp = nb * W

    def to_sub(t):
        return t.reshape(B, L, d, H, Dh).transpose(0, 2, 3, 1, 4)

    qs = jnp.pad(to_sub(q), ((0, 0), (0, 0), (0, 0), (0, Lp - L), (0, 0)))
    qs = qs.reshape(B, d, H, nb, W, Dh)

    def key_blocks(t):
        tp = jnp.pad(to_sub(t), ((0, 0), (0, 0), (0, 0), (W, Lp - L), (0, 0)))
        tp = tp.reshape(B, d, H, nb + 1, W, Dh)
        return jnp.concatenate([tp[:, :, :, :-1], tp[:, :, :, 1:]], axis=4)

    kb = key_blocks(k)
    vb = key_blocks(v)
    scores = jnp.einsum('bdhnqe,bdhnke->bdhnqk', qs, kb)

    qi = jnp.arange(W)[None, :, None]
    kj = jnp.arange(2 * W)[None, None, :]
    blk = jnp.arange(nb)[:, None, None]
    dist = qi + W - kj
    valid = (dist >= 0) & (dist <= W) & (blk * W + kj - W >= 0)
    scores = jnp.where(valid, scores, MASK_VALUE)

    lse = jax.nn.logsumexp(scores, axis=-1)
    p = jnp.exp(scores - lse[..., None])
    o = jnp.einsum('bdhnqk,bdhnke->bdhnqe', p, vb)

    o = o.reshape(B, d, H, Lp, Dh)[:, :, :, :L]
    lse = lse.reshape(B, d, H, Lp)[:, :, :, :L]
    o = o.transpose(0, 3, 1, 2, 4).reshape(B, S, H, Dh)
    lse = lse.transpose(0, 3, 1, 2).reshape(B, S, H)
    return o, lse


def dilated_attention_mixer(h, w_qkv, w_o, cos, sin):
    B, S, D = h.shape
    qkv = (h @ w_qkv).astype(jnp.float32).reshape(B, S, N_GROUPS, 3, N_HEADS, HEAD_DIM)
    outs, lses = [], []
    for g in range(N_GROUPS):
        q = apply_rope(qkv[:, :, g, 0], cos, sin) * (HEAD_DIM ** -0.5)
        k = apply_rope(qkv[:, :, g, 1], cos, sin)
        v = qkv[:, :, g, 2]
        o, lse = dilated_window_attention(q, k, v, DILATIONS[g], WINDOWS[g] // DILATIONS[g])
        outs.append(o)
        lses.append(lse)
    wts = jax.nn.softmax(jnp.stack(lses, axis=0), axis=0)
    o = jnp.sum(wts[..., None] * jnp.stack(outs, axis=0), axis=0)
    return o.reshape(B, S, D).astype(h.dtype) @ w_o


def multiscale_pool_mixer(h, w_group, scale):
    B, S, D = h.shape
    hf = h.astype(jnp.float32)
    csum = jnp.concatenate([jnp.zeros((B, 1, D), jnp.float32), jnp.cumsum(hf, axis=1)], axis=1)
    t = jnp.arange(S)
    outs = []
    for g, P in enumerate(POOL_SIZES):
        sl = slice(g * POOL_CH, (g + 1) * POOL_CH)
        lo = jnp.maximum(t + 1 - P, 0)
        cnt = (t + 1 - lo).astype(jnp.float32)
        c_g = csum[:, :, sl]
        win_sum = c_g[:, 1:] - jnp.take(c_g, lo, axis=1)
        outs.append(win_sum / cnt[None, :, None] - hf[..., sl])
    y = jnp.stack(outs, axis=2)
    y = jnp.einsum('bsgc,gcd->bsgd', y, w_group.astype(jnp.float32)).reshape(B, S, D)
    return (y * scale.astype(jnp.float32)).astype(h.dtype)


def swiglu(h, w_gate, w_up, w_down):
    return (jax.nn.silu(h @ w_gate) * (h @ w_up)) @ w_down


def moe_swiglu(h, w_router, w_gate, w_up, w_down):
    B, S, D = h.shape
    N = B * S
    NK = N * TOP_K
    hf = h.reshape(N, D)
    logits = (hf @ w_router).astype(jnp.float32)
    top_val, top_idx = lax.top_k(logits, TOP_K)
    gates = jax.nn.softmax(top_val, axis=-1)

    flat_e = top_idx.reshape(NK).astype(jnp.int32)
    flat_t = jnp.repeat(jnp.arange(N, dtype=jnp.int32), TOP_K)
    flat_g = gates.reshape(NK)
    order = jnp.argsort(flat_e)
    e_s, t_s, g_s = flat_e[order], flat_t[order], flat_g[order]

    counts = jnp.bincount(flat_e, length=N_EXPERTS)
    starts = jnp.cumsum(counts) - counts
    padded = ((counts + MOE_BLOCK - 1) // MOE_BLOCK) * MOE_BLOCK
    pends = jnp.cumsum(padded)
    pstarts = pends - padded
    dest = pstarts[e_s] + (jnp.arange(NK, dtype=jnp.int32) - starts[e_s])

    n_blocks = -(-NK // MOE_BLOCK) + N_EXPERTS
    cap = n_blocks * MOE_BLOCK
    buf_tok = jnp.zeros((cap,), jnp.int32).at[dest].set(t_s)
    buf_gate = jnp.zeros((cap,), jnp.float32).at[dest].set(g_s)
    block_e = jnp.minimum(
        jnp.searchsorted(pends, jnp.arange(n_blocks) * MOE_BLOCK, side='right'),
        N_EXPERTS - 1).astype(jnp.int32)

    def run_block(args):
        tok, gate, e = args
        y = swiglu(hf[tok], w_gate[e], w_up[e], w_down[e])
        return y * gate[:, None].astype(y.dtype)

    y = lax.map(run_block, (buf_tok.reshape(n_blocks, MOE_BLOCK),
                            buf_gate.reshape(n_blocks, MOE_BLOCK), block_e))
    out = jnp.zeros((N, D), h.dtype).at[buf_tok].add(y.reshape(cap, D).astype(h.dtype))
    return out.reshape(B, S, D)


def setup_inputs(seed: int = 0) -> dict:
    key = jax.random.key(seed)
    ks = jax.random.split(key, 16)
    n_even = (DEPTH + 1) // 2
    n_odd = DEPTH // 2
    f32 = jnp.float32

    def nrm(k, shape, fan_in):
        return jax.random.normal(k, shape, f32) * (fan_in ** -0.5)

    def gain(k, shape):
        return 1.0 + 0.1 * jax.random.normal(k, shape, f32)

    return {
        'x': jax.random.normal(ks[0], (BATCH, SEQ, D_MODEL), f32),
        'mix_norm': gain(ks[1], (DEPTH, D_MODEL)),
        'ffn_norm': gain(ks[2], (DEPTH, D_MODEL)),
        'attn_w_qkv': nrm(ks[3], (n_even, D_MODEL, N_GROUPS * 3 * D_MODEL), D_MODEL),
        'attn_w_o': nrm(ks[4], (n_even, D_MODEL, D_MODEL), D_MODEL),
        'pool_w': nrm(ks[5], (n_odd, N_POOL_GROUPS, POOL_CH, POOL_CH), POOL_CH),
        'pool_scale': gain(ks[6], (n_odd, D_MODEL)),
        'dense_w_gate': nrm(ks[7], (n_even, D_MODEL, D_FF), D_MODEL),
        'dense_w_up': nrm(ks[8], (n_even, D_MODEL, D_FF), D_MODEL),
        'dense_w_down': nrm(ks[9], (n_even, D_FF, D_MODEL), D_FF),
        'moe_router': nrm(ks[10], (n_odd, D_MODEL, N_EXPERTS), D_MODEL),
        'moe_w_gate': nrm(ks[11], (n_odd, N_EXPERTS, D_MODEL, D_FF_EXPERT), D_MODEL),
        'moe_w_up': nrm(ks[12], (n_odd, N_EXPERTS, D_MODEL, D_FF_EXPERT), D_MODEL),
        'moe_w_down': nrm(ks[13], (n_odd, N_EXPERTS, D_FF_EXPERT, D_MODEL), D_FF_EXPERT),
        'final_norm': gain(ks[14], (D_MODEL,)),
    }


def reference(x, mix_norm, ffn_norm, attn_w_qkv, attn_w_o, pool_w, pool_scale,
              dense_w_gate, dense_w_up, dense_w_down, moe_router, moe_w_gate,
              moe_w_up, moe_w_down, final_norm):
    cos, sin = rope_tables(x.shape[1])
    for i in range(DEPTH):
        h = rmsnorm(x, mix_norm[i])
        j = i // N_MIXERS
        if i % N_MIXERS == 0:
            x = x + dilated_attention_mixer(h, attn_w_qkv[j], attn_w_o[j], cos, sin)
        else:
            x = x + multiscale_pool_mixer(h, pool_w[j], pool_scale[j])
        h = rmsnorm(x, ffn_norm[i])
        f = i // 2
        if i % 2 == 0:
            x = x + swiglu(h, dense_w_gate[f], dense_w_up[f], dense_w_down[f])
        else:
            x = x + moe_swiglu(h, moe_router[f], moe_w_gate[f], moe_w_up[f], moe_w_down[f])
    return rmsnorm(x, final_norm)
```

```cpp
#include <hip/hip_runtime.h>
#include <cstdio>
#include <cstdint>

#ifndef DEBUG_CHECK
#define DEBUG_CHECK 0
#endif

#define LAS __attribute__((address_space(3)))
#define GAS __attribute__((address_space(1)))
typedef unsigned short bf16_t;
typedef short bf16x8 __attribute__((ext_vector_type(8)));
typedef short s16x4 __attribute__((ext_vector_type(4)));
typedef float f32x4 __attribute__((ext_vector_type(4)));
typedef float f32x2 __attribute__((ext_vector_type(2)));
typedef unsigned u32x4 __attribute__((ext_vector_type(4)));
typedef unsigned u32x2 __attribute__((ext_vector_type(2)));

constexpr int NTOK = 32768, DM = 1024, SEQ = 2048, NHEAD = 16, HDIM = 64;
constexpr int NQKV = 9216, DFF = 2816, DFFE = 3584, NEXP = 8;
constexpr int HTOK = 16384;
constexpr float RMS_EPS = 1e-6f;
constexpr float QSCALE = 0.125f * 1.4426950408889634f;
constexpr int RING_BYTES = 131072, MISC_OFF = RING_BYTES + 320, LDS_BYTES = 147456;
constexpr int MAXSLOT = 67584;

constexpr size_t MiB = 1u << 20;
constexpr size_t WS_CTL = 0, CTL_ZERO_BYTES = 1 * MiB;
constexpr size_t WS_ROPE = 1 * MiB;
constexpr size_t WS_SSP = 2 * MiB;
constexpr size_t WS_RT = 4 * MiB;
constexpr size_t RT_E = 0, RT_RANK = 256 * 1024, RT_GATE = 512 * 1024, RT_R = 768 * 1024, RT_SLOT = 896 * 1024, RT_GSLOT = 1152 * 1024;
constexpr size_t WS_LSE = 6 * MiB;
constexpr size_t WS_WQKV = 10 * MiB, WS_WO = 46 * MiB, WS_WPOOL = 50 * MiB, WS_WDGU = 51 * MiB, WS_WDD = 73 * MiB, WS_WMGU = 84 * MiB, WS_WMD = 196 * MiB;
constexpr size_t WS_HB = 252 * MiB;
constexpr size_t WS_QKVB = 316 * MiB;
constexpr size_t WS_OPART = 604 * MiB;
constexpr size_t WS_XG = 316 * MiB;
constexpr size_t WS_ACT = 380 * MiB;
constexpr size_t WS_AG = 252 * MiB;
constexpr size_t WS_Y = 316 * MiB;
constexpr size_t WS_ACT2 = 448 * MiB;
constexpr size_t WS_END = 910 * MiB;
constexpr size_t WS_SNAP = 912 * MiB;
constexpr int CW_CNT = 1024;
constexpr int CW_DBG = 2048;
constexpr int CW_BAR = 4096;

__device__ __forceinline__ unsigned f2bf(float f) { unsigned u = __builtin_bit_cast(unsigned, f); return (u + 0x7fffu + ((u >> 16) & 1u)) >> 16; }
__device__ __forceinline__ unsigned pk2(float lo, float hi) { return f2bf(lo) | (f2bf(hi) << 16); }
__device__ __forceinline__ float bf2f(unsigned short b) { return __builtin_bit_cast(float, (unsigned)b << 16); }
__device__ __forceinline__ unsigned cvt_pk_bf16(float lo, float hi) { unsigned r; asm volatile("v_cvt_pk_bf16_f32 %0, %1, %2" : "=v"(r) : "v"(lo), "v"(hi)); return r; }
__device__ __forceinline__ float wave_sum(float v) {
#pragma unroll
    for (int o = 1; o < 64; o <<= 1) v += __shfl_xor(v, o);
    return v;
}
__device__ __forceinline__ float wave_max(float v) {
#pragma unroll
    for (int o = 1; o < 64; o <<= 1) v = fmaxf(v, __shfl_xor(v, o));
    return v;
}
#define LDS_WAIT() asm volatile("s_waitcnt lgkmcnt(0)" ::: "memory")
#define VM_WAIT() asm volatile("s_waitcnt vmcnt(0)" ::: "memory")

#define XB_TMO      128
#define XB_XCNT(j)  (256  + 64 * (j))
#define XB_XSUB(j)  (1280 + 64 * (j))
#define XB_XGEN(j)  (2304 + 64 * (j))
#define XB_TOP      3328
#define XB_TOPGEN   3392
#define XCD_BAR_WORDS 3456
#define XB_SPIN_CAP (1u << 22)
__device__ __forceinline__ unsigned xb_ld(unsigned* p)              { return __hip_atomic_load(p, __ATOMIC_RELAXED, __HIP_MEMORY_SCOPE_AGENT); }
__device__ __forceinline__ unsigned xb_add(unsigned* p, unsigned v) { return __hip_atomic_fetch_add(p, v, __ATOMIC_RELAXED, __HIP_MEMORY_SCOPE_AGENT); }
__device__ __forceinline__ unsigned xb_xcc_id() { return (unsigned)__builtin_amdgcn_s_getreg((3 << 11) | 20) & 0xFu; }
#define XB_SPIN(cond, bar) do { unsigned _sp = 0; while (cond) { __builtin_amdgcn_s_sleep(1); \
    if ((++_sp & 255u) == 0u) { if (xb_ld(&(bar)[XB_TMO])) break; if (_sp > XB_SPIN_CAP) { atomicAdd(&(bar)[XB_TMO], 1u); break; } } } } while (0)
struct XcdBarrier { unsigned* bar; unsigned x; volatile LAS unsigned* st; };
__device__ __forceinline__ XcdBarrier xcd_barrier_post(unsigned* bar, volatile LAS unsigned* st) {
    XcdBarrier b; b.bar = bar; b.x = xb_xcc_id(); b.st = st;
    if (threadIdx.x == 0) (void)xb_add(&bar[XB_XCNT(b.x)], 1u);
    return b;
}
__device__ __forceinline__ void xcd_barrier_complete(unsigned* bar, unsigned x, unsigned& nloc, unsigned& nx) {
    const unsigned G = gridDim.x * gridDim.y * gridDim.z;
    unsigned sum, cnt, mine, sp = 0u;
    for (;;) {
        sum = 0u; cnt = 0u; mine = 0u;
#pragma unroll
        for (unsigned j = 0; j < 16; ++j) { const unsigned c = xb_ld(&bar[XB_XCNT(j)]); sum += c; cnt += (c > 0u) ? 1u : 0u; mine = (j == x) ? c : mine; }
        if (sum == G) break;
        __builtin_amdgcn_s_sleep(1);
        if ((++sp & 255u) == 0u) { if (xb_ld(&bar[XB_TMO])) break; if (sp > XB_SPIN_CAP) { atomicAdd(&bar[XB_TMO], 1u); break; } }
    }
    nloc = mine > 0u ? mine : 1u; nx = cnt > 0u ? cnt : 1u;
}
__device__ __forceinline__ void xcd_barrier(const XcdBarrier& b) {
    asm volatile("s_waitcnt vmcnt(0)" ::: "memory");
    __syncthreads();
    if (threadIdx.x == 0) {
        unsigned* bar = b.bar;
        __builtin_amdgcn_s_waitcnt(0);
        unsigned nloc = b.st[0], nx = b.st[1];
        if (nloc == 0u) { xcd_barrier_complete(bar, b.x, nloc, nx); b.st[0] = nloc; b.st[1] = nx; }
        const unsigned old = xb_add(&bar[XB_XSUB(b.x)], 1u);
        const unsigned gen = old / nloc;
        if (old + 1u == (gen + 1u) * nloc) {
            __builtin_amdgcn_fence(__ATOMIC_RELEASE, "agent");
            asm volatile("s_waitcnt vmcnt(0)" ::: "memory");
            const unsigned og = xb_add(&bar[XB_TOP], 1u);
            const unsigned tg = og / nx;
            if (og + 1u == (tg + 1u) * nx) xb_add(&bar[XB_TOPGEN], 1u);
            else XB_SPIN(xb_ld(&bar[XB_TOPGEN]) == tg, bar);
            __builtin_amdgcn_fence(__ATOMIC_ACQUIRE, "agent");
            xb_add(&bar[XB_XGEN(b.x)], 1u);
            asm volatile("s_waitcnt vmcnt(0)" ::: "memory");
        } else {
            XB_SPIN(xb_ld(&bar[XB_XGEN(b.x)]) == gen, bar);
            __builtin_amdgcn_fence(__ATOMIC_ACQUIRE, "agent");
            asm volatile("s_waitcnt vmcnt(0)" ::: "memory");
        }
    }
    __syncthreads();
}

namespace pg8 {
#define PG8_LAS __attribute__((address_space(3)))
constexpr int BM = 256, BK = 64, HALF = 128, HTB = HALF * BK * 2, STAGE_BYTES = 8 * HTB, NXCD = 8, WGM = 8;
__host__ __device__ __forceinline__ int lds_byte(int r, int c) { const int st = (r >> 4) * 2 + (c >> 5), rr = r & 15, cc = c & 31, ob = rr * 64 + cc * 2; return st * 1024 + (ob ^ (((ob >> 9) & 1) << 5)); }
__host__ __device__ __forceinline__ void stage_rc(int b, int& R, int& C) { const int st = b / 1024, sb = b % 1024, swz = sb ^ (((sb >> 9) & 1) << 5); R = (st >> 1) * 16 + swz / 64; C = (st & 1) * 32 + (swz % 64) / 2; }
__host__ __device__ __forceinline__ int perm32(int rho) { const int n = rho >> 4, i = rho & 15; return 8 * (i >> 2) + 4 * n + (i & 3); }

struct Unit { int pm, pn; const char* a; const char* b; };
struct Gemm { int K, lda, ldb; };

struct TileMap {
    int nM, nN, nwg, G, c;
    __device__ __forceinline__ void init(int nM_, int nN_, int G_, int c_) { nM = nM_; nN = nN_; nwg = nM * nN; G = G_; c = c_; }
    __device__ __forceinline__ bool map(int i, int& pm, int& pn) const {
        const long L = (long)i * G + c; if (L >= nwg) return false;
        int wgid = (int)L; { const int q = nwg / NXCD, r = nwg % NXCD, xcd = wgid % NXCD, off = wgid / NXCD; wgid = (xcd < r ? xcd * (q + 1) : r * (q + 1) + (xcd - r) * q) + off; }
        const int nig = WGM * nN, gid = wgid / nig, fm = gid * WGM, gsz = (nM - fm) < WGM ? (nM - fm) : WGM;
        pm = fm + ((wgid % nig) % gsz); pn = (wgid % nig) / gsz; return true;
    }
};
struct SchedPlain {
    TileMap tm; const char* A; const char* Bt; size_t atile, btile;
    __device__ __forceinline__ bool next(int i, Unit& u) const { if (!tm.map(i, u.pm, u.pn)) return false; u.a = A + (size_t)u.pm * atile; u.b = Bt + (size_t)u.pn * btile; return true; }
    __device__ __forceinline__ void a_ready(const Unit&) const {}
    __device__ __forceinline__ void done(const Unit&) const {}
};
struct SchedPool {
    TileMap tm; const char* A; const char* Bt; size_t atile;
    __device__ __forceinline__ bool next(int i, Unit& u) const { if (!tm.map(i, u.pm, u.pn)) return false; u.a = A + (size_t)u.pm * atile + (size_t)u.pn * 512; u.b = Bt + (size_t)u.pn * 131072; return true; }
    __device__ __forceinline__ void a_ready(const Unit&) const {}
    __device__ __forceinline__ void done(const Unit&) const {}
};
struct SchedMoe {
    TileMap tm; const char* A; const char* Bt; size_t atile, btile, estride; const LAS int* pt;
    __device__ __forceinline__ bool next(int i, Unit& u) const { if (!tm.map(i, u.pm, u.pn)) return false; int e = 0;
#pragma unroll
        for (int k = 1; k < 8; ++k) e += (pt[k] <= u.pm) ? 1 : 0;
        u.a = A + (size_t)u.pm * atile; u.b = Bt + (size_t)e * estride + (size_t)u.pn * btile; return true; }
    __device__ __forceinline__ void a_ready(const Unit&) const {}
    __device__ __forceinline__ void done(const Unit&) const {}
};

struct EpiQKV {
    static constexpr bool PERM = true, AFTER_DRAIN = false;
    bf16_t* qkvb; const float* rope;
    __device__ __forceinline__ void operator()(const f32x4 (&acc)[2][2][4][2], const Unit& u, int wr, int wc, int fr, int fq) const {
        const int g = u.pn / 12, rem = u.pn - 12 * g, t = rem >> 2, cq = (rem & 3) * 256, dsh = 2 * g, Lg = SEQ >> dsh;
        bf16_t* buf = qkvb + (size_t)(g * 3 + t) * ((size_t)HTOK * DM);
#pragma unroll
        for (int bj = 0; bj < 2; ++bj) { const int cb = cq + bj * HALF + wc * 32 + 8 * fq, h = cb >> 6, p0 = cb & 63;
#pragma unroll
            for (int ai = 0; ai < 2; ++ai)
#pragma unroll
                for (int m = 0; m < 4; ++m) { const int row = u.pm * BM + ai * HALF + wr * 64 + m * 16 + fr, bl = row >> 11, s = row & 2047, r = s & ((1 << dsh) - 1), j = s >> dsh, seq = ((bl << dsh) + r) * NHEAD + h;
                    f32x4 v0 = acc[ai][bj][m][0], v1 = acc[ai][bj][m][1];
                    if (t < 2) { const f32x4* cs = (const f32x4*)(rope + ((size_t)s * 32 + (p0 >> 1)) * 2); const f32x4 c0 = cs[0], c1 = cs[1];
                        f32x4 w0, w1; w0[0] = v0[0] * c0[0] - v0[1] * c0[1]; w0[1] = v0[1] * c0[0] + v0[0] * c0[1]; w0[2] = v0[2] * c0[2] - v0[3] * c0[3]; w0[3] = v0[3] * c0[2] + v0[2] * c0[3];
                        w1[0] = v1[0] * c1[0] - v1[1] * c1[1]; w1[1] = v1[1] * c1[0] + v1[0] * c1[1]; w1[2] = v1[2] * c1[2] - v1[3] * c1[3]; w1[3] = v1[3] * c1[2] + v1[2] * c1[3];
                        if (t == 0) { w0 = w0 * QSCALE; w1 = w1 * QSCALE; } v0 = w0; v1 = w1; }
                    u32x4 w; w.x = cvt_pk_bf16(v0[0], v0[1]); w.y = cvt_pk_bf16(v0[2], v0[3]); w.z = cvt_pk_bf16(v1[0], v1[1]); w.w = cvt_pk_bf16(v1[2], v1[3]);
                    *(u32x4*)(buf + ((size_t)seq * Lg + j) * HDIM + p0) = w; } }
    }
};
template <bool SCALE, bool XG, bool SSP> struct EpiRes {
    static constexpr bool PERM = true, AFTER_DRAIN = false;
    const float* xres; float* xout; const float* colscale; bf16_t* xg; const float* gain; float* ssp;
    __device__ __forceinline__ void operator()(const f32x4 (&acc)[2][2][4][2], const Unit& u, int wr, int wc, int fr, int fq) const {
        const int col0 = u.pn * BM + wc * 32 + 8 * fq;
#pragma unroll
        for (int ai = 0; ai < 2; ++ai)
#pragma unroll
            for (int m = 0; m < 4; ++m) { const int row = u.pm * BM + ai * HALF + wr * 64 + m * 16 + fr; const size_t off = (size_t)row * DM + col0; float ss = 0.f;
#pragma unroll
                for (int bj = 0; bj < 2; ++bj) { f32x4 v0 = acc[ai][bj][m][0], v1 = acc[ai][bj][m][1];
                    if (SCALE) { v0 = v0 * *(const f32x4*)(colscale + col0 + bj * HALF); v1 = v1 * *(const f32x4*)(colscale + col0 + bj * HALF + 4); }
                    v0 = v0 + *(const f32x4*)(xres + off + bj * HALF); v1 = v1 + *(const f32x4*)(xres + off + bj * HALF + 4);
                    *(f32x4*)(xout + off + bj * HALF) = v0; *(f32x4*)(xout + off + bj * HALF + 4) = v1;
                    if (SSP) ss += (v0[0] * v0[0] + v0[1] * v0[1]) + (v0[2] * v0[2] + v0[3] * v0[3]) + (v1[0] * v1[0] + v1[1] * v1[1]) + (v1[2] * v1[2] + v1[3] * v1[3]);
                    if (XG) { const f32x4 a = v0 * *(const f32x4*)(gain + col0 + bj * HALF), b = v1 * *(const f32x4*)(gain + col0 + bj * HALF + 4); u32x4 w; w.x = cvt_pk_bf16(a[0], a[1]); w.y = cvt_pk_bf16(a[2], a[3]); w.z = cvt_pk_bf16(b[0], b[1]); w.w = cvt_pk_bf16(b[2], b[3]);
                        *(u32x4*)(xg + off + bj * HALF) = w; } }
                if (SSP) { ss += __shfl_xor(ss, 16); ss += __shfl_xor(ss, 32); if (fq == 0) ssp[(size_t)row * 16 + u.pn * 4 + wc] = ss; } }
    }
};
template <bool NORM> struct EpiGU {
    static constexpr bool PERM = true, AFTER_DRAIN = false;
    bf16_t* act; int ldact; const float* ssp;
    __device__ __forceinline__ void operator()(const f32x4 (&acc)[2][2][4][2], const Unit& u, int wr, int wc, int fr, int fq) const {
        const int col0 = u.pn * HALF + wc * 32 + 8 * fq;
#pragma unroll
        for (int ai = 0; ai < 2; ++ai)
#pragma unroll
            for (int m = 0; m < 4; ++m) { const int row = u.pm * BM + ai * HALF + wr * 64 + m * 16 + fr; float r = 1.f;
                if (NORM) { const f32x4* p = (const f32x4*)(ssp + (size_t)row * 16); const f32x4 a = p[0], b = p[1], c = p[2], d = p[3];
                    const float s = ((a[0] + a[1]) + (a[2] + a[3])) + ((b[0] + b[1]) + (b[2] + b[3])) + ((c[0] + c[1]) + (c[2] + c[3])) + ((d[0] + d[1]) + (d[2] + d[3]));
                    r = __builtin_amdgcn_rsqf(s * (1.0f / DM) + RMS_EPS); }
                float o[8];
#pragma unroll
                for (int n = 0; n < 2; ++n)
#pragma unroll
                    for (int e = 0; e < 4; ++e) { const float gt = acc[ai][0][m][n][e] * r, up = acc[ai][1][m][n][e] * r;
                        const float sg = gt * __builtin_amdgcn_rcpf(1.0f + __builtin_amdgcn_exp2f(-1.4426950408889634f * gt)); o[4 * n + e] = sg * up; }
                u32x4 w; w.x = cvt_pk_bf16(o[0], o[1]); w.y = cvt_pk_bf16(o[2], o[3]); w.z = cvt_pk_bf16(o[4], o[5]); w.w = cvt_pk_bf16(o[6], o[7]);
                *(u32x4*)(act + (size_t)row * ldact + col0) = w; }
    }
};
struct EpiMoeDown {
    static constexpr bool PERM = true, AFTER_DRAIN = false;
    bf16_t* y; const float* gate;
    __device__ __forceinline__ void operator()(const f32x4 (&acc)[2][2][4][2], const Unit& u, int wr, int wc, int fr, int fq) const {
        const int col0 = u.pn * BM + wc * 32 + 8 * fq;
#pragma unroll
        for (int ai = 0; ai < 2; ++ai)
#pragma unroll
            for (int m = 0; m < 4; ++m) { const int row = u.pm * BM + ai * HALF + wr * 64 + m * 16 + fr; const float gt = gate[row];
#pragma unroll
                for (int bj = 0; bj < 2; ++bj) { const f32x4 v0 = acc[ai][bj][m][0] * gt, v1 = acc[ai][bj][m][1] * gt;
                    u32x4 w; w.x = cvt_pk_bf16(v0[0], v0[1]); w.y = cvt_pk_bf16(v0[2], v0[3]); w.z = cvt_pk_bf16(v1[0], v1[1]); w.w = cvt_pk_bf16(v1[2], v1[3]);
                    *(u32x4*)(y + (size_t)row * DM + col0 + bj * HALF) = w; } }
    }
};

template <class Epi, class Sched, bool ALIGN_EPI = false, bool SP2 = false>
__device__ __forceinline__ void gemm_phase(PG8_LAS unsigned char* lds, const Gemm g, const Sched& S, const Epi& E) {
    int tid_ = threadIdx.x; asm volatile("" : "+v"(tid_));
    const int tid = tid_, wid = __builtin_amdgcn_readfirstlane(tid >> 6), lane = tid & 63, wr = wid >> 2, wc = wid & 3, fr = lane & 15, fq = lane >> 4;
    const int K = g.K, nt = K / BK, lda = g.lda, ldb = g.ldb;
    unsigned voffA[2], voffB[2];
#pragma unroll
    for (int i = 0; i < 2; ++i) { int R, C; stage_rc(tid * 16 + i * 8192, R, C); const int Rb = Epi::PERM ? ((R & ~31) + perm32(R & 31)) : R;
        voffA[i] = (unsigned)(R * lda + C) * 2u; voffB[i] = (unsigned)(Rb * ldb + C) * 2u; }
    const size_t kstep = (size_t)(BK * 2);
    const size_t hstepA = (size_t)HALF * lda * 2, hstepB = (size_t)HALF * ldb * 2;
    const unsigned ldsw = (unsigned)wid * 1024u;
    const int aoff = lds_byte(wr * 64 + fr, fq * 8), boff = lds_byte(wc * 32 + fr, fq * 8);
#define PG8_SA(b, h) (((b) * 2 + (h)) * HTB)
#define PG8_SB(b, h) ((4 + (b) * 2 + (h)) * HTB)
#define PG8_STAGE(bufoff, gbase, voff) do { _Pragma("unroll") for (int _i = 0; _i < 2; ++_i) \
        __builtin_amdgcn_global_load_lds((const unsigned*)((const char*)(gbase) + (voff)[_i]), (PG8_LAS unsigned*)(lds + (bufoff) + ldsw + _i * 8192), 16, 0, 0); } while (0)
#define PG8_LDA(dst, b, h) do { _Pragma("unroll") for (int m = 0; m < 4; ++m) _Pragma("unroll") for (int k = 0; k < 2; ++k) dst[m][k] = *(const PG8_LAS bf16x8*)(lds + PG8_SA(b, h) + aoff + m * 2048 + k * 1024); } while (0)
#define PG8_LDB(dst, b, h) do { _Pragma("unroll") for (int n = 0; n < 2; ++n) _Pragma("unroll") for (int k = 0; k < 2; ++k) dst[n][k] = *(const PG8_LAS bf16x8*)(lds + PG8_SB(b, h) + boff + n * 2048 + k * 1024); } while (0)
#define PG8_MMA(ai, bj, At, Bt) do { __builtin_amdgcn_s_setprio(1); _Pragma("unroll") for (int m = 0; m < 4; ++m) _Pragma("unroll") for (int n = 0; n < 2; ++n) _Pragma("unroll") for (int k = 0; k < 2; ++k) \
        acc[ai][bj][m][n] = __builtin_amdgcn_mfma_f32_16x16x32_bf16(Bt[n][k], At[m][k], acc[ai][bj][m][n], 0, 0, 0); __builtin_amdgcn_s_setprio(0); } while (0)
#define PG8_WAIT_V(n) asm volatile("s_waitcnt vmcnt(" #n ")" ::: "memory")
#define PG8_WAIT_L(n) asm volatile("s_waitcnt lgkmcnt(" #n ")" ::: "memory")
#define PG8_BAR __builtin_amdgcn_s_barrier()
#define PG8_SCHED __builtin_amdgcn_sched_barrier(0)
    Unit cur, nxt; int ui = 0;
    if (!S.next(0, cur)) return;
    f32x4 acc[2][2][4][2];
#pragma unroll
    for (int a = 0; a < 2; ++a)
#pragma unroll
        for (int b = 0; b < 2; ++b)
#pragma unroll
            for (int m = 0; m < 4; ++m)
#pragma unroll
                for (int n = 0; n < 2; ++n) acc[a][b][m][n] = (f32x4){0.f, 0.f, 0.f, 0.f};
    bf16x8 At[4][2], B0[2][2], B1[2][2];
    const char* cA = cur.a; const char* cB = cur.b;
    S.a_ready(cur);
    if constexpr (SP2) {
        PG8_STAGE(PG8_SB(0, 0), cB, voffB); PG8_STAGE(PG8_SB(0, 1), cB + hstepB, voffB); PG8_STAGE(PG8_SA(0, 0), cA, voffA); PG8_STAGE(PG8_SA(0, 1), cA + hstepA, voffA);
        if (wr == 1) PG8_BAR;
        PG8_WAIT_V(2); PG8_BAR;
        PG8_STAGE(PG8_SB(1, 0), cB + kstep, voffB); PG8_STAGE(PG8_SA(1, 0), cA + kstep, voffA); PG8_STAGE(PG8_SB(1, 1), cB + hstepB + kstep, voffB);
        PG8_WAIT_V(6); PG8_BAR;
    } else {
        PG8_STAGE(PG8_SB(0, 0), cB, voffB); PG8_STAGE(PG8_SA(0, 0), cA, voffA); PG8_STAGE(PG8_SB(0, 1), cB + hstepB, voffB); PG8_STAGE(PG8_SA(0, 1), cA + hstepA, voffA);
        if (wr == 1) PG8_BAR;
        PG8_WAIT_V(4); PG8_BAR;
        PG8_STAGE(PG8_SB(1, 0), cB + kstep, voffB); PG8_STAGE(PG8_SA(1, 0), cA + kstep, voffA); PG8_STAGE(PG8_SB(1, 1), cB + hstepB + kstep, voffB);
        PG8_WAIT_V(6); PG8_BAR;
    }
    for (;;) {
        const bool has_next = S.next(ui + 1, nxt);
        const char* nA = has_next ? nxt.a : cA; const char* nB = has_next ? nxt.b : cB;
#pragma nounroll
        for (int t = 0; t < nt; t += 2) {
            const bool last = (t == nt - 2);
            const char* a1 = cA + (size_t)(t + 1) * kstep;
            const char* a2 = last ? nA : cA + (size_t)(t + 2) * kstep; const char* b2 = last ? nB : cB + (size_t)(t + 2) * kstep;
            const char* a3 = a2 + kstep; const char* b3 = b2 + kstep;
            if (last && has_next) S.a_ready(nxt);
            if constexpr (SP2) {
            PG8_LDB(B0, 0, 0); PG8_LDB(B1, 0, 1); PG8_SCHED; PG8_LDA(At, 0, 0); PG8_STAGE(PG8_SA(1, 1), a1 + hstepA, voffA);
            PG8_WAIT_V(8); PG8_WAIT_L(0); PG8_BAR; PG8_MMA(0, 0, At, B0); PG8_MMA(0, 1, At, B1); PG8_BAR; PG8_SCHED;
            PG8_LDA(At, 0, 1); PG8_STAGE(PG8_SB(0, 0), b2, voffB); PG8_STAGE(PG8_SB(0, 1), b2 + hstepB, voffB); PG8_STAGE(PG8_SA(0, 0), a2, voffA);
            PG8_WAIT_V(8); PG8_WAIT_L(0); PG8_BAR; PG8_MMA(1, 0, At, B0); PG8_MMA(1, 1, At, B1); PG8_BAR; PG8_SCHED;
            PG8_LDB(B0, 1, 0); PG8_LDB(B1, 1, 1); PG8_SCHED; PG8_LDA(At, 1, 0); PG8_STAGE(PG8_SA(0, 1), a2 + hstepA, voffA);
            PG8_WAIT_V(8); PG8_WAIT_L(0); PG8_BAR; PG8_MMA(0, 0, At, B0); PG8_MMA(0, 1, At, B1); PG8_BAR; PG8_SCHED;
            PG8_LDA(At, 1, 1); PG8_STAGE(PG8_SB(1, 0), b3, voffB); PG8_STAGE(PG8_SB(1, 1), b3 + hstepB, voffB); PG8_STAGE(PG8_SA(1, 0), a3, voffA);
            PG8_WAIT_V(8); PG8_WAIT_L(0); PG8_BAR; PG8_MMA(1, 0, At, B0); PG8_MMA(1, 1, At, B1); PG8_BAR; PG8_SCHED;
            } else {
            PG8_LDB(B0, 0, 0); PG8_SCHED; PG8_LDA(At, 0, 0); PG8_STAGE(PG8_SA(1, 1), a1 + hstepA, voffA);
            PG8_WAIT_L(8); PG8_BAR; PG8_WAIT_L(0); PG8_MMA(0, 0, At, B0); PG8_BAR; PG8_SCHED;
            PG8_LDB(B1, 0, 1); PG8_STAGE(PG8_SB(0, 0), b2, voffB);
            PG8_BAR; PG8_WAIT_L(0); PG8_MMA(0, 1, At, B1); PG8_BAR;
            PG8_LDA(At, 0, 1); PG8_STAGE(PG8_SA(0, 0), a2, voffA);
            PG8_BAR; PG8_WAIT_L(0); PG8_MMA(1, 0, At, B0); PG8_BAR; PG8_SCHED;
            PG8_STAGE(PG8_SB(0, 1), b2 + hstepB, voffB);
            PG8_WAIT_V(6); PG8_BAR; PG8_MMA(1, 1, At, B1); PG8_BAR;
            PG8_LDB(B0, 1, 0); PG8_SCHED; PG8_LDA(At, 1, 0); PG8_STAGE(PG8_SA(0, 1), a2 + hstepA, voffA);
            PG8_WAIT_L(8); PG8_BAR; PG8_WAIT_L(0); PG8_MMA(0, 0, At, B0); PG8_BAR; PG8_SCHED;
            PG8_LDB(B1, 1, 1); PG8_STAGE(PG8_SB(1, 0), b3, voffB);
            PG8_BAR; PG8_WAIT_L(0); PG8_MMA(0, 1, At, B1); PG8_BAR;
            PG8_LDA(At, 1, 1); PG8_STAGE(PG8_SA(1, 0), a3, voffA);
            PG8_BAR; PG8_WAIT_L(0); PG8_MMA(1, 0, At, B0); PG8_BAR; PG8_SCHED;
            PG8_STAGE(PG8_SB(1, 1), b3 + hstepB, voffB);
            PG8_WAIT_V(6); PG8_BAR; PG8_MMA(1, 1, At, B1); PG8_BAR;
            }
        }
        if constexpr (ALIGN_EPI) { if (wr == 0) PG8_BAR; }
        if constexpr (!Epi::AFTER_DRAIN) { E(acc, cur, wr, wc, fr, fq); S.done(cur); }
        if (!has_next) break;
#pragma unroll
        for (int a = 0; a < 2; ++a)
#pragma unroll
            for (int b = 0; b < 2; ++b)
#pragma unroll
                for (int m = 0; m < 4; ++m)
#pragma unroll
                    for (int n = 0; n < 2; ++n) acc[a][b][m][n] = (f32x4){0.f, 0.f, 0.f, 0.f};
        cur = nxt; cA = nA; cB = nB; ++ui;
        if constexpr (ALIGN_EPI) { if (wr == 1) PG8_BAR; }
    }
    PG8_WAIT_V(0);
    if constexpr (!ALIGN_EPI) { if (wr == 0) PG8_BAR; }
    PG8_BAR;
    if constexpr (Epi::AFTER_DRAIN) { E.fused(acc, cur, wr, wc, fr, fq, lds, wid, lane); S.done(cur); }
#undef PG8_SA
#undef PG8_SB
#undef PG8_STAGE
#undef PG8_LDA
#undef PG8_LDB
#undef PG8_MMA
#undef PG8_WAIT_V
#undef PG8_WAIT_L
#undef PG8_BAR
#undef PG8_SCHED
}
}

namespace att {
__device__ __forceinline__ int koff(int row, int ch) { return row * 128 + ((ch ^ (((row >> 1) & 3) << 1)) << 4); }
constexpr int LDS_K = 0, LDS_V = 32768;
__device__ __forceinline__ s16x4 vtr(const LAS unsigned char* p) { return __builtin_bit_cast(s16x4, __builtin_amdgcn_ds_read_tr16_b64_v4i16((LAS s16x4*)p)); }

__device__ __forceinline__ void decode_unit(int u, int& g, int& seq, int& jt) {
    g = u >> 11; const int ug = u & 2047;
    if (g == 0) { seq = ug >> 4; jt = (ug + seq) & 15; } else if (g == 1) { seq = ug >> 2; jt = (ug + seq) & 3; } else { seq = ug; jt = 0; }
}
__device__ __forceinline__ void load_tile(u32x4 (&pf)[8], const bf16_t* qkvb, int u, int tid) {
    int g, seq, jt; decode_unit(u, g, seq, jt); const int Lg = SEQ >> (2 * g);
    const bf16_t* kb = qkvb + (size_t)(g * 3 + 1) * ((size_t)HTOK * DM) + ((size_t)seq * Lg + (size_t)jt * 128 - 128) * HDIM;
    const bf16_t* vb = kb + (size_t)HTOK * DM;
#pragma unroll
    for (int i = 0; i < 4; ++i) { const int q = tid + 512 * i; const bool ok = (jt > 0) || (q >= 1024);
        pf[i] = ok ? *(const u32x4*)(kb + (size_t)q * 8) : (u32x4){0u, 0u, 0u, 0u}; pf[4 + i] = ok ? *(const u32x4*)(vb + (size_t)q * 8) : (u32x4){0u, 0u, 0u, 0u}; }
}
__device__ __forceinline__ void store_tile(const u32x4 (&pf)[8], LAS unsigned char* lds, int tid) {
#pragma unroll
    for (int i = 0; i < 4; ++i) { const int q = tid + 512 * i, row = q >> 3, ch = q & 7; *(LAS u32x4*)(lds + LDS_K + koff(row, ch)) = pf[i]; *(LAS u32x4*)(lds + LDS_V + koff(row, ch)) = pf[4 + i]; }
}
__device__ __forceinline__ void compute_unit(LAS unsigned char* lds, const bf16_t* qkvb, bf16_t* opart, float* lse, int u, int wid, int lane) {
    int g, seq, jt; decode_unit(u, g, seq, jt); const int dsh = 2 * g, Lg = SEQ >> dsh;
    const int fr = lane & 15, grp = lane >> 4;
    const int h = seq & 15, br = seq >> 4, bl = br >> dsh, r = br & ((1 << dsh) - 1);
    const int j = jt * 128 + wid * 16 + fr;
    const bf16_t* qp = qkvb + (size_t)(g * 3) * ((size_t)HTOK * DM) + ((size_t)seq * Lg + j) * HDIM + 8 * grp;
    const bf16x8 q0 = *(const bf16x8*)qp, q1 = *(const bf16x8*)(qp + 32);
    const int t0 = (jt == 0) ? (8 - wid) : 0;
    f32x4 S[9];
#pragma unroll
    for (int t = 0; t < 9; ++t) {
        if (t >= t0) { const int kr = wid * 16 + t * 16 + fr;
            const bf16x8 k0 = *(const LAS bf16x8*)(lds + LDS_K + koff(kr, grp)), k1 = *(const LAS bf16x8*)(lds + LDS_K + koff(kr, 4 + grp));
            f32x4 a = __builtin_amdgcn_mfma_f32_16x16x32_bf16(k0, q0, (f32x4){0.f, 0.f, 0.f, 0.f}, 0, 0, 0);
            S[t] = __builtin_amdgcn_mfma_f32_16x16x32_bf16(k1, q1, a, 0, 0, 0);
        } else S[t] = (f32x4){0.f, 0.f, 0.f, 0.f};
    }
    const float NEG = -1e30f; float mx = NEG;
#pragma unroll
    for (int t = 0; t < 9; ++t)
#pragma unroll
        for (int e = 0; e < 4; ++e) { const int diff = 16 * t + 4 * grp + e - fr; const bool ok = (t >= t0) && (diff >= 0) && (diff <= 128);
            S[t][e] = ok ? S[t][e] : NEG; mx = fmaxf(mx, S[t][e]); }
    mx = fmaxf(mx, __shfl_xor(mx, 16)); mx = fmaxf(mx, __shfl_xor(mx, 32));
    float ls = 0.f;
#pragma unroll
    for (int t = 0; t < 9; ++t)
#pragma unroll
        for (int e = 0; e < 4; ++e) { const float p = (S[t][e] > -1e29f) ? __builtin_amdgcn_exp2f(S[t][e] - mx) : 0.f; S[t][e] = p; ls += p; }
    ls += __shfl_xor(ls, 16); ls += __shfl_xor(ls, 32);
    f32x4 O[4];
#pragma unroll
    for (int dt = 0; dt < 4; ++dt) O[dt] = (f32x4){0.f, 0.f, 0.f, 0.f};
    const int iq = fr >> 2, ip = fr & 3;
#pragma unroll
    for (int c = 0; c < 5; ++c) {
        if (2 * c + 1 >= t0) {
            u32x4 pw; pw.x = cvt_pk_bf16(S[2 * c][0], S[2 * c][1]); pw.y = cvt_pk_bf16(S[2 * c][2], S[2 * c][3]);
            if (c < 4) { pw.z = cvt_pk_bf16(S[2 * c + 1][0], S[2 * c + 1][1]); pw.w = cvt_pk_bf16(S[2 * c + 1][2], S[2 * c + 1][3]); } else { pw.z = 0u; pw.w = 0u; }
            const bf16x8 pf = __builtin_bit_cast(bf16x8, pw);
            const int vrow = wid * 16 + 32 * c + 4 * grp + iq;
#pragma unroll
            for (int dt = 0; dt < 4; ++dt) {
                const s16x4 lo = vtr(lds + LDS_V + koff(vrow, 2 * dt + (ip >> 1)) + 8 * (ip & 1));
                s16x4 hi = (s16x4){0, 0, 0, 0};
                if (c < 4) hi = vtr(lds + LDS_V + koff(vrow + 16, 2 * dt + (ip >> 1)) + 8 * (ip & 1));
                const bf16x8 vf = (bf16x8){lo[0], lo[1], lo[2], lo[3], hi[0], hi[1], hi[2], hi[3]};
                O[dt] = __builtin_amdgcn_mfma_f32_16x16x32_bf16(vf, pf, O[dt], 0, 0, 0);
            }
        }
    }
    const float inv = 1.0f / ls;
    const size_t tokrow = (size_t)bl * SEQ + ((size_t)j << dsh) + r;
    bf16_t* op = opart + (size_t)g * ((size_t)HTOK * DM) + tokrow * DM + h * HDIM + 4 * grp;
#pragma unroll
    for (int dt = 0; dt < 4; ++dt) { u32x2 w; w.x = cvt_pk_bf16(O[dt][0] * inv, O[dt][1] * inv); w.y = cvt_pk_bf16(O[dt][2] * inv, O[dt][3] * inv); *(u32x2*)(op + 16 * dt) = w; }
    if (grp == 0) lse[(size_t)g * ((size_t)HTOK * NHEAD) + tokrow * NHEAD + h] = mx + __builtin_amdgcn_logf(ls);
}
__device__ __forceinline__ void attn_phase(LAS unsigned char* lds, const bf16_t* qkvb, bf16_t* opart, float* lse, int G, int c) {
    int tid_ = threadIdx.x; asm volatile("" : "+v"(tid_));
    const int tid = tid_, wid = __builtin_amdgcn_readfirstlane(tid >> 6), lane = tid & 63;
    constexpr int NU = 6144;
    u32x4 pf[8];
    int u = c;
    if (u < NU) load_tile(pf, qkvb, u, tid);
    for (; u < NU; u += G) {
        store_tile(pf, lds, tid);
        __syncthreads();
        if (u + G < NU) load_tile(pf, qkvb, u + G, tid);
        compute_unit(lds, qkvb, opart, lse, u, wid, lane);
        __syncthreads();
    }
}
}
struct Args { const float* in[15]; float* out; unsigned char* ws; int ph_lo, ph_hi, li, pad; };
struct Frame {
    LAS unsigned char* lds; unsigned* ctl; int tid, lane, wave, vcu, G;
    const float *x_in, *mix_norm, *ffn_norm, *w_qkv, *w_o, *pool_w, *pool_scale, *dg, *du, *dd, *router, *mg, *mu, *md, *final_norm;
    float* xo; unsigned char* ws;
};
typedef const __attribute__((address_space(4))) Args* KArgs;
__device__ __forceinline__ void build_frame(Frame& F, LAS unsigned char* lds) {
    KArgs A = (KArgs)__builtin_amdgcn_kernarg_segment_ptr(); asm volatile("" : "+s"(A));
    F.lds = lds; F.tid = threadIdx.x; asm volatile("" : "+v"(F.tid)); F.lane = F.tid & 63; F.wave = __builtin_amdgcn_readfirstlane(F.tid >> 6);
    F.G = gridDim.x; { const int bx = blockIdx.x; F.vcu = (F.G % 8 == 0) ? (bx % 8) * (F.G / 8) + bx / 8 : bx; }
    F.ws = A->ws; F.ctl = (unsigned*)(A->ws + WS_CTL); F.xo = A->out;
    F.x_in = A->in[0]; F.mix_norm = A->in[1]; F.ffn_norm = A->in[2]; F.w_qkv = A->in[3]; F.w_o = A->in[4]; F.pool_w = A->in[5]; F.pool_scale = A->in[6];
    F.dg = A->in[7]; F.du = A->in[8]; F.dd = A->in[9]; F.router = A->in[10]; F.mg = A->in[11]; F.mu = A->in[12]; F.md = A->in[13]; F.final_norm = A->in[14];
}
__device__ __forceinline__ void transpose_item(const float* W, int K, int N, bf16_t* WT, int mode, LAS float* scr, int item, int lane) {
    const int nblk = N / 32, kb = item / nblk, nb = item - kb * nblk, k0 = 64 * kb, n0 = 32 * nb;
    int rbase = n0, rstride = 1;
    if (mode == 1) rbase = (n0 >> 7) * 256 + (n0 & 127);
    else if (mode == 2) rbase = (n0 >> 7) * 256 + 128 + (n0 & 127);
    else if (mode == 3) { const int t = (n0 % 3072) >> 10; if (t < 2) { rbase = (n0 & ~63) + ((n0 >> 5) & 1); rstride = 2; } }
#pragma unroll 8
    for (int i = 0; i < 32; ++i) { const int kk = 2 * i + (lane >> 5); scr[kk * 33 + (lane & 31)] = W[(size_t)(k0 + kk) * N + n0 + (lane & 31)]; }
    LDS_WAIT(); asm volatile("" ::: "memory");
    const int c = lane & 7;
#pragma unroll
    for (int j = 0; j < 4; ++j) { const int n = (lane >> 3) + 8 * j; const LAS float* s = scr + (8 * c) * 33 + n;
        u32x4 o; o.x = pk2(s[0 * 33], s[1 * 33]); o.y = pk2(s[2 * 33], s[3 * 33]); o.z = pk2(s[4 * 33], s[5 * 33]); o.w = pk2(s[6 * 33], s[7 * 33]);
        *(u32x4*)(WT + (size_t)(rbase + rstride * n) * K + k0 + 8 * c) = o; }
    LDS_WAIT(); asm volatile("" ::: "memory");
}
struct ConvDesc { const float* src; bf16_t* dst; int K, N, mode, nbatch; size_t sstride, dstride; };
__device__ __forceinline__ void convert_list(Frame& F, const ConvDesc* d, int nd) {
    LAS float* scr = (LAS float*)(F.lds + F.wave * 16384);
    const int gw = F.vcu * 8 + F.wave, NGW = F.G * 8;
    for (int k = 0; k < nd; ++k) { const int per = (d[k].K / 64) * (d[k].N / 32), tot = per * d[k].nbatch;
        for (int it = gw; it < tot; it += NGW) { const int b = it / per, r = it - b * per;
            transpose_item(d[k].src + (size_t)b * d[k].sstride, d[k].K, d[k].N, d[k].dst + (size_t)b * d[k].dstride, d[k].mode, scr, r, F.lane); } }
}
__device__ __forceinline__ void convert_moe(Frame& F, int f) {
    LAS float* scr = (LAS float*)(F.lds + F.wave * 16384);
    const int gw = F.vcu * 8 + F.wave, NGW = F.G * 8;
    const size_t EW = (size_t)DM * DFFE;
    constexpr int per = (DM / 64) * (DFFE / 32);
    for (int it = gw; it < 3 * 8 * per; it += NGW) { const int which = it / (8 * per), rr = it - which * 8 * per, e = rr / per, r = rr - e * per;
        if (which == 0)      transpose_item(F.mg + ((size_t)f * 8 + e) * EW, DM, DFFE, (bf16_t*)(F.ws + WS_WMGU) + (size_t)e * 2 * EW, 1, scr, r, F.lane);
        else if (which == 1) transpose_item(F.mu + ((size_t)f * 8 + e) * EW, DM, DFFE, (bf16_t*)(F.ws + WS_WMGU) + (size_t)e * 2 * EW, 2, scr, r, F.lane);
        else                 transpose_item(F.md + ((size_t)f * 8 + e) * EW, DFFE, DM, (bf16_t*)(F.ws + WS_WMD) + (size_t)e * EW, 0, scr, r, F.lane); }
}
__device__ __forceinline__ void convert_static(Frame& F) {
    LAS float* scr = (LAS float*)(F.lds + F.wave * 16384);
    const int gw = F.vcu * 8 + F.wave, NGW = F.G * 8;
    constexpr int P_QKV = (DM / 64) * (NQKV / 32), P_O = (DM / 64) * (DM / 32), P_POOL = 4 * 8, P_DG = (DM / 64) * (DFF / 32), P_DD = (DFF / 64) * (DM / 32);
    constexpr int T0 = 2 * P_QKV, T1 = T0 + 2 * P_O, T2 = T1 + 8 * P_POOL, T3 = T2 + 2 * P_DG, T4 = T3 + 2 * P_DG, T5 = T4 + 2 * P_DD;
    for (int it = gw; it < T5; it += NGW) {
        if (it < T0) { const int l = it / P_QKV, r = it - l * P_QKV; transpose_item(F.w_qkv + (size_t)l * DM * NQKV, DM, NQKV, (bf16_t*)(F.ws + WS_WQKV) + (size_t)l * NQKV * DM, 3, scr, r, F.lane); }
        else if (it < T1) { const int q = it - T0, l = q / P_O, r = q - l * P_O; transpose_item(F.w_o + (size_t)l * DM * DM, DM, DM, (bf16_t*)(F.ws + WS_WO) + (size_t)l * DM * DM, 0, scr, r, F.lane); }
        else if (it < T2) { const int q = it - T1, l = q / P_POOL, r = q - l * P_POOL; transpose_item(F.pool_w + (size_t)l * 65536, 256, 256, (bf16_t*)(F.ws + WS_WPOOL) + (size_t)l * 65536, 0, scr, r, F.lane); }
        else if (it < T3) { const int q = it - T2, l = q / P_DG, r = q - l * P_DG; transpose_item(F.dg + (size_t)l * DM * DFF, DM, DFF, (bf16_t*)(F.ws + WS_WDGU) + (size_t)l * 2 * DFF * DM, 1, scr, r, F.lane); }
        else if (it < T4) { const int q = it - T3, l = q / P_DG, r = q - l * P_DG; transpose_item(F.du + (size_t)l * DM * DFF, DM, DFF, (bf16_t*)(F.ws + WS_WDGU) + (size_t)l * 2 * DFF * DM, 2, scr, r, F.lane); }
        else { const int q = it - T4, l = q / P_DD, r = q - l * P_DD; transpose_item(F.dd + (size_t)l * DFF * DM, DFF, DM, (bf16_t*)(F.ws + WS_WDD) + (size_t)l * DM * DFF, 0, scr, r, F.lane); }
    }
}
__device__ __forceinline__ void rope_table(Frame& F) {
    float* tab = (float*)(F.ws + WS_ROPE);
    for (int i = F.vcu * 512 + F.tid; i < SEQ * 32; i += F.G * 512) { const int s = i >> 5, k = i & 31;
        const float inv = powf(10000.0f, -(float)(2 * k) / 64.0f), ang = (float)s * inv; tab[2 * i] = cosf(ang); tab[2 * i + 1] = sinf(ang); }
}
__device__ __forceinline__ void rms_row_to_bf16(const float* xrow, const float* gain, bf16_t* orow, int lane) {
    const f32x4* xr = (const f32x4*)xrow + lane; const f32x4* gr = (const f32x4*)gain + lane;
    f32x4 v[4]; float s = 0.f;
#pragma unroll
    for (int j = 0; j < 4; ++j) { v[j] = xr[64 * j]; s += (v[j][0] * v[j][0] + v[j][1] * v[j][1]) + (v[j][2] * v[j][2] + v[j][3] * v[j][3]); }
    const float r = 1.0f / sqrtf(wave_sum(s) * (1.0f / DM) + RMS_EPS);
    u32x2* o8 = (u32x2*)orow + lane;
#pragma unroll
    for (int j = 0; j < 4; ++j) { const f32x4 g = gr[64 * j]; u32x2 w; w.x = pk2(v[j][0] * r * g[0], v[j][1] * r * g[1]); w.y = pk2(v[j][2] * r * g[2], v[j][3] * r * g[3]); o8[64 * j] = w; }
}
__device__ __forceinline__ void norm_rows(Frame& F, const float* x, const float* gain, bf16_t* out) {
    const int gw = F.vcu * 8 + F.wave, NGW = F.G * 8;
    for (int m = gw; m < NTOK; m += NGW) rms_row_to_bf16(x + (size_t)m * DM, gain, out + (size_t)m * DM, F.lane);
}
__device__ __forceinline__ void merge_half(Frame& F, int hb) {
    const bf16_t* op = (const bf16_t*)(F.ws + WS_OPART); const float* lse = (const float*)(F.ws + WS_LSE); bf16_t* out = (bf16_t*)(F.ws + WS_HB) + (size_t)hb * HTOK * DM;
    for (int it = F.vcu * 512 + F.tid; it < HTOK * 128; it += F.G * 512) { const int row = it >> 7, ci = it & 127, h = ci >> 3;
        const float l0 = lse[(size_t)row * 16 + h], l1 = lse[(size_t)HTOK * 16 + (size_t)row * 16 + h], l2 = lse[(size_t)2 * HTOK * 16 + (size_t)row * 16 + h];
        const float mx = fmaxf(l0, fmaxf(l1, l2)); float w0 = __builtin_amdgcn_exp2f(l0 - mx), w1 = __builtin_amdgcn_exp2f(l1 - mx), w2 = __builtin_amdgcn_exp2f(l2 - mx);
        const float inv = 1.0f / (w0 + w1 + w2); w0 *= inv; w1 *= inv; w2 *= inv;
        const size_t off = (size_t)row * DM + ci * 8;
        const u32x4 a = *(const u32x4*)(op + off), b = *(const u32x4*)(op + (size_t)HTOK * DM + off), c = *(const u32x4*)(op + (size_t)2 * HTOK * DM + off);
        u32x4 o;
#pragma unroll
        for (int k = 0; k < 4; ++k) { const float lo = w0 * bf2f((unsigned short)(a[k] & 0xffffu)) + w1 * bf2f((unsigned short)(b[k] & 0xffffu)) + w2 * bf2f((unsigned short)(c[k] & 0xffffu));
            const float hi = w0 * bf2f((unsigned short)(a[k] >> 16)) + w1 * bf2f((unsigned short)(b[k] >> 16)) + w2 * bf2f((unsigned short)(c[k] >> 16)); o[k] = pk2(lo, hi); }
        *(u32x4*)(out + off) = o; }
}
__device__ __forceinline__ void pool_prep(Frame& F, const float* gain) {
    const float* x = F.xo; const float* ssp = (const float*)(F.ws + WS_SSP); bf16_t* pa = (bf16_t*)(F.ws + WS_HB);
    const int gw = F.vcu * 8 + F.wave, NGW = F.G * 8, lane = F.lane;
    for (int item = gw; item < 16 * 32 * 4; item += NGW) {
        const int b = item >> 7, rem = item & 127, ch = rem >> 2, g = rem & 3, P = 2 << g, t0 = ch * 64, c = 256 * g + 4 * lane;
        const size_t row0 = (size_t)b * SEQ;
        float rA = 0.f, rB = 0.f;
        { const int t = t0 - 16 + lane; if (t >= 0) { const f32x4* p = (const f32x4*)(ssp + (row0 + t) * 16); const f32x4 a = p[0], bb = p[1], cc = p[2], d = p[3];
              rA = 1.0f / sqrtf((((a[0] + a[1]) + (a[2] + a[3])) + ((bb[0] + bb[1]) + (bb[2] + bb[3])) + ((cc[0] + cc[1]) + (cc[2] + cc[3])) + ((d[0] + d[1]) + (d[2] + d[3]))) * (1.0f / DM) + RMS_EPS); }
          const int t2 = t0 + 48 + lane; if (lane < 16) { const f32x4* p = (const f32x4*)(ssp + (row0 + t2) * 16); const f32x4 a = p[0], bb = p[1], cc = p[2], d = p[3];
              rB = 1.0f / sqrtf((((a[0] + a[1]) + (a[2] + a[3])) + ((bb[0] + bb[1]) + (bb[2] + bb[3])) + ((cc[0] + cc[1]) + (cc[2] + cc[3])) + ((d[0] + d[1]) + (d[2] + d[3]))) * (1.0f / DM) + RMS_EPS); } }
#define POOL_R(t) (((t) - (t0 - 16)) < 64 ? __shfl(rA, (t) - (t0 - 16)) : __shfl(rB, (t) - (t0 + 48)))
        const f32x4 gm = *(const f32x4*)(gain + c);
        f32x4 S = (f32x4){0.f, 0.f, 0.f, 0.f};
        for (int t = (t0 - P > 0 ? t0 - P : 0); t < t0; ++t) { const float r = POOL_R(t); S = S + *(const f32x4*)(x + (row0 + t) * DM + c) * r * gm; }
#pragma unroll 4
        for (int t = t0; t < t0 + 64; ++t) {
            const float r = POOL_R(t); const f32x4 cur = *(const f32x4*)(x + (row0 + t) * DM + c) * r * gm; S = S + cur;
            if (t - P >= 0) { const float r2 = POOL_R(t - P); S = S - *(const f32x4*)(x + (row0 + t - P) * DM + c) * r2 * gm; }
            const float ic = 1.0f / (float)(t + 1 < P ? t + 1 : P); const f32x4 o = S * ic - cur;
            u32x2 w; w.x = pk2(o[0], o[1]); w.y = pk2(o[2], o[3]); *(u32x2*)(pa + (row0 + t) * DM + c) = w; }
#undef POOL_R
    }
}
__device__ __forceinline__ void router_pass(Frame& F, int lp, const float* gain, const float* wr) {
    const float* x = F.xo; unsigned char* rt = F.ws + WS_RT; unsigned* cnt = F.ctl + CW_CNT + 64 * lp;
    LAS int* sel = (LAS int*)F.lds;
    const int lane = F.lane;
    float wg[4][4][8];
#pragma unroll
    for (int j = 0; j < 4; ++j)
#pragma unroll
        for (int q = 0; q < 4; ++q) { const int c = 4 * lane + 256 * j + q; const float g = gain[c]; const f32x4 a = *(const f32x4*)(wr + (size_t)c * 8), b = *(const f32x4*)(wr + (size_t)c * 8 + 4);
            wg[j][q][0] = g * a[0]; wg[j][q][1] = g * a[1]; wg[j][q][2] = g * a[2]; wg[j][q][3] = g * a[3]; wg[j][q][4] = g * b[0]; wg[j][q][5] = g * b[1]; wg[j][q][6] = g * b[2]; wg[j][q][7] = g * b[3]; }
    for (int tok0 = F.vcu * 128; tok0 < NTOK; tok0 += F.G * 128) {
        for (int tk = 0; tk < 16; ++tk) { const int tl = F.wave * 16 + tk, token = tok0 + tl;
            const f32x4* xr = (const f32x4*)(x + (size_t)token * DM) + lane; float s = 0.f, lg[8];
#pragma unroll
            for (int e = 0; e < 8; ++e) lg[e] = 0.f;
#pragma unroll
            for (int j = 0; j < 4; ++j) { const f32x4 v = xr[64 * j]; s += (v[0] * v[0] + v[1] * v[1]) + (v[2] * v[2] + v[3] * v[3]);
#pragma unroll
                for (int q = 0; q < 4; ++q)
#pragma unroll
                    for (int e = 0; e < 8; ++e) lg[e] += v[q] * wg[j][q][e]; }
            s = wave_sum(s); const float r = 1.0f / sqrtf(s * (1.0f / DM) + RMS_EPS);
#pragma unroll
            for (int e = 0; e < 8; ++e) lg[e] = wave_sum(lg[e]) * r;
            int i0 = 0; float v0 = lg[0];
#pragma unroll
            for (int e = 1; e < 8; ++e) if (lg[e] > v0) { v0 = lg[e]; i0 = e; }
            int i1 = -1; float v1 = -3.0e38f;
#pragma unroll
            for (int e = 0; e < 8; ++e) if (e != i0 && lg[e] > v1) { v1 = lg[e]; i1 = e; }
            const float g0 = 1.0f / (1.0f + expf(v1 - v0)), g1 = 1.0f - g0;
            if (lane == 0) { sel[2 * tl] = i0; sel[2 * tl + 1] = i1; ((f32x2*)(rt + RT_GATE))[token] = (f32x2){g0, g1}; ((float*)(rt + RT_R))[token] = r; }
        }
        __syncthreads();
        if (F.wave == 0) {
            int cl[8]; int rk[4], ex[4];
#pragma unroll
            for (int e = 0; e < 8; ++e) cl[e] = 0;
#pragma unroll
            for (int it = 0; it < 4; ++it) { const int e = sel[it * 64 + lane]; ex[it] = e; rk[it] = 0;
#pragma unroll
                for (int ee = 0; ee < 8; ++ee) { const unsigned long long m = __ballot(e == ee); if (e == ee) rk[it] = cl[ee] + __popcll(m & ((1ull << lane) - 1ull)); cl[ee] += __popcll(m); } }
            int mine = 0;
#pragma unroll
            for (int ee = 0; ee < 8; ++ee) mine = (lane == ee) ? cl[ee] : mine;
            int base = 0; if (lane < 8) base = (int)__hip_atomic_fetch_add(cnt + lane, (unsigned)mine, __ATOMIC_RELAXED, __HIP_MEMORY_SCOPE_AGENT);
#pragma unroll
            for (int it = 0; it < 4; ++it) { const int a = it * 64 + lane, token = tok0 + (a >> 1), k = a & 1; const int gb = __shfl(base, ex[it]);
                ((int*)(rt + RT_E))[2 * token + k] = ex[it]; ((int*)(rt + RT_RANK))[2 * token + k] = gb + rk[it]; }
        }
        __syncthreads();
    }
}
__device__ __forceinline__ int expert_tiles_lds(Frame& F, int lp) {
    const unsigned* cnt = F.ctl + CW_CNT + 64 * lp; int acc = 0; LAS int* pt = (LAS int*)(F.lds + MISC_OFF) + 16;
#pragma unroll
    for (int e = 0; e < 8; ++e) { if (F.tid == 0) pt[e] = acc; const int c = __builtin_amdgcn_readfirstlane((int)__hip_atomic_load(cnt + e, __ATOMIC_RELAXED, __HIP_MEMORY_SCOPE_AGENT)); acc += (c + 255) >> 8; }
    if (F.tid == 0) pt[8] = acc;
    __syncthreads();
    return acc;
}
__device__ __forceinline__ void expert_tiles(Frame& F, int lp, int (&pt)[9]) {
    const unsigned* cnt = F.ctl + CW_CNT + 64 * lp; int acc = 0;
#pragma unroll
    for (int e = 0; e < 8; ++e) { pt[e] = acc; const int c = (int)__hip_atomic_load(cnt + e, __ATOMIC_RELAXED, __HIP_MEMORY_SCOPE_AGENT); acc += (c + 255) >> 8; }
    pt[8] = acc;
}
__device__ __forceinline__ void gather_pass(Frame& F, int lp, const float* gain) {
    const float* x = F.xo; unsigned char* rt = F.ws + WS_RT; bf16_t* ag = (bf16_t*)(F.ws + WS_AG);
    int pt[9]; expert_tiles(F, lp, pt);
    const int gw = F.vcu * 8 + F.wave, NGW = F.G * 8, lane = F.lane;
    f32x4 gn[4];
#pragma unroll
    for (int j = 0; j < 4; ++j) gn[j] = ((const f32x4*)gain)[lane + 64 * j];
    for (int token = gw; token < NTOK; token += NGW) {
        const int e0 = ((const int*)(rt + RT_E))[2 * token], e1 = ((const int*)(rt + RT_E))[2 * token + 1];
        const int k0 = ((const int*)(rt + RT_RANK))[2 * token], k1 = ((const int*)(rt + RT_RANK))[2 * token + 1];
        const f32x2 gt = ((const f32x2*)(rt + RT_GATE))[token]; const float r = ((const float*)(rt + RT_R))[token];
        int p0 = 0, p1 = 0;
#pragma unroll
        for (int e = 0; e < 8; ++e) { p0 = (e == e0) ? pt[e] : p0; p1 = (e == e1) ? pt[e] : p1; }
        const int d0 = p0 * 256 + k0, d1 = p1 * 256 + k1;
        const f32x4* xr = (const f32x4*)(x + (size_t)token * DM) + lane;
        u32x2* o0 = (u32x2*)(ag + (size_t)d0 * DM) + lane; u32x2* o1 = (u32x2*)(ag + (size_t)d1 * DM) + lane;
#pragma unroll
        for (int j = 0; j < 4; ++j) { const f32x4 v = xr[64 * j] * r * gn[j]; u32x2 w; w.x = pk2(v[0], v[1]); w.y = pk2(v[2], v[3]); o0[64 * j] = w; o1[64 * j] = w; }
        if (lane == 0) { ((int*)(rt + RT_SLOT))[2 * token] = d0; ((int*)(rt + RT_SLOT))[2 * token + 1] = d1; ((float*)(rt + RT_GSLOT))[d0] = gt[0]; ((float*)(rt + RT_GSLOT))[d1] = gt[1]; }
    }
}
__device__ __forceinline__ void combine_pass(Frame& F, const float* gain, bool last) {
    float* x = F.xo; const unsigned char* rt = F.ws + WS_RT; const bf16_t* y = (const bf16_t*)(F.ws + WS_Y); bf16_t* hb = (bf16_t*)(F.ws + WS_HB);
    const int gw = F.vcu * 8 + F.wave, NGW = F.G * 8, lane = F.lane;
    for (int token = gw; token < NTOK; token += NGW) {
        const int d0 = ((const int*)(rt + RT_SLOT))[2 * token], d1 = ((const int*)(rt + RT_SLOT))[2 * token + 1];
        f32x4* xr = (f32x4*)(x + (size_t)token * DM) + lane; const u32x2* y0 = (const u32x2*)(y + (size_t)d0 * DM) + lane; const u32x2* y1 = (const u32x2*)(y + (size_t)d1 * DM) + lane;
        f32x4 v[4]; float s = 0.f;
#pragma unroll
        for (int j = 0; j < 4; ++j) { const u32x2 a = y0[64 * j], b = y1[64 * j]; f32x4 t = xr[64 * j];
            t[0] += bf2f((unsigned short)(a.x & 0xffffu)) + bf2f((unsigned short)(b.x & 0xffffu)); t[1] += bf2f((unsigned short)(a.x >> 16)) + bf2f((unsigned short)(b.x >> 16));
            t[2] += bf2f((unsigned short)(a.y & 0xffffu)) + bf2f((unsigned short)(b.y & 0xffffu)); t[3] += bf2f((unsigned short)(a.y >> 16)) + bf2f((unsigned short)(b.y >> 16));
            v[j] = t; s += (t[0] * t[0] + t[1] * t[1]) + (t[2] * t[2] + t[3] * t[3]); }
        const float r = 1.0f / sqrtf(wave_sum(s) * (1.0f / DM) + RMS_EPS);
#pragma unroll
        for (int j = 0; j < 4; ++j) { const f32x4 g = ((const f32x4*)gain)[lane + 64 * j];
            if (last) xr[64 * j] = v[j] * r * g;
            else { xr[64 * j] = v[j]; u32x2 w; w.x = pk2(v[j][0] * r * g[0], v[j][1] * r * g[1]); w.y = pk2(v[j][2] * r * g[2], v[j][3] * r * g[3]); ((u32x2*)(hb + (size_t)token * DM))[lane + 64 * j] = w; } }
    }
}

constexpr int NPH = 17;
enum { PH_PRE = 0, PH_QKV0, PH_ATT0, PH_MRG0, PH_QKV1, PH_ATT1, PH_MRG1, PH_WO, PH_DGU, PH_DDOWN, PH_PPREP, PH_PGEMM, PH_ROUTE, PH_GATHER, PH_MGU, PH_MDOWN, PH_COMB };

__global__ void __launch_bounds__(512, 2) fwd(Args args) {
    extern __shared__ __attribute__((aligned(16))) unsigned char lds_raw[];
    LAS unsigned char* const lds = (LAS unsigned char*)lds_raw;
    for (int u = threadIdx.x; u < (LDS_BYTES - RING_BYTES) / 4; u += 512) ((LAS unsigned*)(lds + RING_BYTES))[u] = 0u;
    __syncthreads();
    XcdBarrier bar = xcd_barrier_post((unsigned*)(args.ws + WS_CTL) + CW_BAR + args.li * XCD_BAR_WORDS, (volatile LAS unsigned*)(lds + MISC_OFF) + 8);
    const int lo = args.ph_lo, hi = args.ph_hi;
#define FRAME() Frame F; build_frame(F, lds); unsigned char* ws = F.ws; bf16_t* HB = (bf16_t*)(ws + WS_HB); (void)HB

    for (int lp = 0; lp < 2; ++lp) {
#define PHID(k) (lp * NPH + (k))
#ifndef PHMASK
#define PHMASK 0x1ffff
#endif
#define IN(k) (((PHMASK >> ((k) >= PH_QKV1 && (k) <= PH_MRG1 ? (k) - 3 : (k))) & 1) && lo <= PHID(k) && PHID(k) < hi)
#define SEAM(k) do { if (PHID(k) + 1 < hi) xcd_barrier(bar); } while (0)
        if (lp == 0 && IN(PH_PRE)) { FRAME(); convert_static(F); convert_moe(F, 0); rope_table(F); norm_rows(F, F.x_in, F.mix_norm, HB); SEAM(PH_PRE); }
        for (int hb = 0; hb < 2; ++hb) {
            if (IN(PH_QKV0 + 3 * hb)) { FRAME();
                pg8::SchedPlain S; S.tm.init(HTOK / 256, NQKV / 256, F.G, (int)blockIdx.x); S.A = (const char*)(HB + (size_t)hb * HTOK * DM); S.Bt = (const char*)(ws + WS_WQKV) + (size_t)lp * NQKV * DM * 2; S.atile = 256 * DM * 2; S.btile = 256 * DM * 2;
                pg8::EpiQKV E{(bf16_t*)(ws + WS_QKVB), (const float*)(ws + WS_ROPE)};
                pg8::gemm_phase<pg8::EpiQKV, pg8::SchedPlain, true, true>(F.lds, pg8::Gemm{DM, DM, DM}, S, E);
                SEAM(PH_QKV0 + 3 * hb);
            }
            if (IN(PH_ATT0 + 3 * hb)) { FRAME(); att::attn_phase(F.lds, (const bf16_t*)(ws + WS_QKVB), (bf16_t*)(ws + WS_OPART), (float*)(ws + WS_LSE), F.G, (int)blockIdx.x); SEAM(PH_ATT0 + 3 * hb); }
            if (IN(PH_MRG0 + 3 * hb)) { FRAME(); merge_half(F, hb); SEAM(PH_MRG0 + 3 * hb); }
        }
        if (IN(PH_WO)) { FRAME();
            pg8::SchedPlain S; S.tm.init(NTOK / 256, DM / 256, F.G, (int)blockIdx.x); S.A = (const char*)HB; S.Bt = (const char*)(ws + WS_WO) + (size_t)lp * DM * DM * 2; S.atile = 256 * DM * 2; S.btile = 256 * DM * 2;
            pg8::EpiRes<false, true, true> E{lp == 0 ? F.x_in : F.xo, F.xo, nullptr, (bf16_t*)(ws + WS_XG), F.ffn_norm + (size_t)(2 * lp) * DM, (float*)(ws + WS_SSP)};
            pg8::gemm_phase<pg8::EpiRes<false, true, true>, pg8::SchedPlain, true, true>(F.lds, pg8::Gemm{DM, DM, DM}, S, E);
            SEAM(PH_WO);
        }
        if (IN(PH_DGU)) { FRAME();
            pg8::SchedPlain S; S.tm.init(NTOK / 256, 2 * DFF / 256, F.G, (int)blockIdx.x); S.A = (const char*)(ws + WS_XG); S.Bt = (const char*)(ws + WS_WDGU) + (size_t)lp * 2 * DFF * DM * 2; S.atile = 256 * DM * 2; S.btile = 256 * DM * 2;
            pg8::EpiGU<true> E{(bf16_t*)(ws + WS_ACT), DFF, (const float*)(ws + WS_SSP)};
            pg8::gemm_phase<pg8::EpiGU<true>, pg8::SchedPlain, true, true>(F.lds, pg8::Gemm{DM, DM, DM}, S, E);
            SEAM(PH_DGU);
        }
        if (IN(PH_DDOWN)) { FRAME();
            pg8::SchedPlain S; S.tm.init(NTOK / 256, DM / 256, F.G, (int)blockIdx.x); S.A = (const char*)(ws + WS_ACT); S.Bt = (const char*)(ws + WS_WDD) + (size_t)lp * DM * DFF * 2; S.atile = (size_t)256 * DFF * 2; S.btile = (size_t)256 * DFF * 2;
            pg8::EpiRes<false, false, true> E{F.xo, F.xo, nullptr, nullptr, nullptr, (float*)(ws + WS_SSP)};
            pg8::gemm_phase<pg8::EpiRes<false, false, true>, pg8::SchedPlain, true, true>(F.lds, pg8::Gemm{DFF, DFF, DFF}, S, E);
            SEAM(PH_DDOWN);
        }
        if (IN(PH_PPREP)) { FRAME(); pool_prep(F, F.mix_norm + (size_t)(2 * lp + 1) * DM); SEAM(PH_PPREP); }
        if (IN(PH_PGEMM)) { FRAME();
            pg8::SchedPool S; S.tm.init(NTOK / 256, 4, F.G, (int)blockIdx.x); S.A = (const char*)HB; S.Bt = (const char*)(ws + WS_WPOOL) + (size_t)lp * 4 * 65536 * 2; S.atile = 256 * DM * 2;
            pg8::EpiRes<true, false, false> E{F.xo, F.xo, F.pool_scale + (size_t)lp * DM, nullptr, nullptr, nullptr};
            pg8::gemm_phase<pg8::EpiRes<true, false, false>, pg8::SchedPool, true, true>(F.lds, pg8::Gemm{256, DM, 256}, S, E);
            SEAM(PH_PGEMM);
        }
        if (IN(PH_ROUTE)) { FRAME(); router_pass(F, lp, F.ffn_norm + (size_t)(2 * lp + 1) * DM, F.router + (size_t)lp * DM * 8); SEAM(PH_ROUTE); }
        if (IN(PH_GATHER)) { FRAME(); gather_pass(F, lp, F.ffn_norm + (size_t)(2 * lp + 1) * DM); SEAM(PH_GATHER); }
        if (IN(PH_MGU)) { FRAME();
            pg8::SchedMoe S; S.pt = (const LAS int*)(F.lds + MISC_OFF) + 16; const int ntile = expert_tiles_lds(F, lp); S.tm.init(ntile, 2 * DFFE / 256, F.G, (int)blockIdx.x); S.A = (const char*)(ws + WS_AG); S.Bt = (const char*)(ws + WS_WMGU); S.atile = 256 * DM * 2; S.btile = 256 * DM * 2; S.estride = (size_t)2 * DFFE * DM * 2;
            pg8::EpiGU<false> E{(bf16_t*)(ws + WS_ACT2), DFFE, nullptr};
            pg8::gemm_phase<pg8::EpiGU<false>, pg8::SchedMoe, true, true>(F.lds, pg8::Gemm{DM, DM, DM}, S, E);
            SEAM(PH_MGU);
        }
        if (IN(PH_MDOWN)) { FRAME();
            pg8::SchedMoe S; S.pt = (const LAS int*)(F.lds + MISC_OFF) + 16; const int ntile = expert_tiles_lds(F, lp); S.tm.init(ntile, DM / 256, F.G, (int)blockIdx.x); S.A = (const char*)(ws + WS_ACT2); S.Bt = (const char*)(ws + WS_WMD); S.atile = (size_t)256 * DFFE * 2; S.btile = (size_t)256 * DFFE * 2; S.estride = (size_t)DM * DFFE * 2;
            pg8::EpiMoeDown E{(bf16_t*)(ws + WS_Y), (const float*)(ws + WS_RT + RT_GSLOT)};
            pg8::gemm_phase<pg8::EpiMoeDown, pg8::SchedMoe, true, true>(F.lds, pg8::Gemm{DFFE, DFFE, DFFE}, S, E);
            SEAM(PH_MDOWN);
        }
        if (IN(PH_COMB)) { FRAME();
            if (lp == 0) { combine_pass(F, F.mix_norm + (size_t)2 * DM, false); convert_moe(F, 1); SEAM(PH_COMB); }
            else combine_pass(F, F.final_norm, true);
        }
#undef PHID
#undef IN
#undef SEAM
    }
}
#if DEBUG_CHECK
namespace dbg {
__device__ __forceinline__ unsigned hsh(unsigned a) { a ^= a >> 16; a *= 0x7feb352dU; a ^= a >> 15; a *= 0x846ca68bU; a ^= a >> 16; return a; }
__device__ __forceinline__ void report(unsigned* d, int id, float err, float tol) { float ratio = err / tol; if (!(ratio <= 1.f)) { if (!(ratio < 1e30f)) ratio = 1e30f; atomicMax(d + id, __float_as_uint(ratio)); } }
__device__ __forceinline__ float silu(float g) { return g / (1.0f + expf(-g)); }
__device__ __forceinline__ void wdot(const bf16_t* a, const float* w, size_t ldw, int K, int lane, float& dot, float& ad) {
    float s = 0.f, t = 0.f; for (int k = lane; k < K; k += 64) { const float p = bf2f(a[k]) * w[(size_t)k * ldw]; s += p; t += fabsf(p); } dot = wave_sum(s); ad = wave_sum(t); }
__device__ __forceinline__ float row_r(const float* xrow, int lane) { float s = 0.f; for (int k = lane; k < DM; k += 64) s += xrow[k] * xrow[k]; return 1.0f / sqrtf(wave_sum(s) * (1.0f / DM) + RMS_EPS); }

__global__ void snap_pos(const float* src, float* snap, unsigned salt) { const unsigned k = blockIdx.x * 64 + threadIdx.x; const unsigned h = hsh(k * 2654435761u + salt); snap[k] = src[(size_t)(h % NTOK) * DM + (hsh(h) % DM)]; }
__global__ void snap_rows(const float* src, float* snap, unsigned salt) { const unsigned k = blockIdx.x; const unsigned row = hsh(k * 2654435761u + salt) % NTOK; for (int c = threadIdx.x; c < DM; c += 64) snap[(size_t)k * DM + c] = src[(size_t)row * DM + c]; }

__global__ void chk_norm(const float* x, const float* gain, const bf16_t* hb, unsigned* d, int id) {
    const int lane = threadIdx.x; const unsigned row = hsh(blockIdx.x * 2654435761u + 11u) % NTOK; const float r = row_r(x + (size_t)row * DM, lane); float e = 0.f;
    for (int c = lane; c < DM; c += 64) { const float ref = x[(size_t)row * DM + c] * r * gain[c]; e = fmaxf(e, fabsf(bf2f(hb[(size_t)row * DM + c]) - ref) / (0.01f * fabsf(ref) + 1e-3f)); }
    e = wave_max(e); if (lane == 0) report(d, id, e, 1.f);
}
__global__ void chk_qkv(const bf16_t* hbh, const float* w, const bf16_t* qkvb, unsigned* d, int id) {
    const int lane = threadIdx.x; const unsigned hh = hsh(blockIdx.x * 2654435761u + 23u); const int row = hh % HTOK, c = hsh(hh) % NQKV;
    const int g = c / 3072, t = (c % 3072) >> 10, h = (c & 1023) >> 6, dd = c & 63, dsh = 2 * g, Lg = SEQ >> dsh;
    const int s = row & 2047, bl = row >> 11, r = s & ((1 << dsh) - 1), j = s >> dsh, seq = ((bl << dsh) + r) * NHEAD + h;
    float ref, tol; int pos;
    if (t < 2) { const int dlo = dd & 31, cb = c - dd; float tlo, thi, a0, a1; wdot(hbh + (size_t)row * DM, w + cb + dlo, NQKV, DM, lane, tlo, a0); wdot(hbh + (size_t)row * DM, w + cb + dlo + 32, NQKV, DM, lane, thi, a1);
        const float ang = (float)s * powf(10000.0f, -(float)(2 * dlo) / 64.0f), cs = cosf(ang), sn = sinf(ang); const float olo = tlo * cs - thi * sn, ohi = thi * cs + tlo * sn;
        ref = dd < 32 ? olo : ohi; tol = 0.01f * (a0 + a1) + 2e-3f; if (t == 0) { ref *= QSCALE; tol *= QSCALE; tol += 1e-3f; } pos = dd < 32 ? 2 * dlo : 2 * dlo + 1; }
    else { float a0; wdot(hbh + (size_t)row * DM, w + c, NQKV, DM, lane, ref, a0); tol = 0.01f * a0 + 2e-3f; pos = dd; }
    const float got = bf2f(qkvb[(size_t)(g * 3 + t) * ((size_t)HTOK * DM) + ((size_t)seq * Lg + j) * HDIM + pos]);
    if (lane == 0) report(d, id, fabsf(got - ref), tol);
}
__global__ void chk_attn(const bf16_t* qkvb, const bf16_t* opart, const float* lse, unsigned* d, int id) {
    const int lane = threadIdx.x; const unsigned hh = hsh(blockIdx.x * 2654435761u + 37u); const int g = blockIdx.x % 3, dsh = 2 * g, Lg = SEQ >> dsh, nseq = (HTOK * NHEAD) / Lg;
    const int seq = hh % nseq; int j = hsh(hh) % Lg; if ((blockIdx.x / 3) % 4 == 0) j = j % 130;
    const size_t GS = (size_t)HTOK * DM; const bf16_t* qb = qkvb + (size_t)(g * 3) * GS + ((size_t)seq * Lg) * HDIM; const bf16_t* kb = qb + GS; const bf16_t* vb = kb + GS;
    float sc[3]; float mx = -1e30f;
    for (int i = 0; i < 3; ++i) { const int kk = lane + 64 * i, jk = j - 128 + kk; sc[i] = -1e30f;
        if (kk <= 128 && jk >= 0) { float s = 0.f; for (int e = 0; e < 64; ++e) s += bf2f(qb[(size_t)j * 64 + e]) * bf2f(kb[(size_t)jk * 64 + e]); sc[i] = s; } mx = fmaxf(mx, sc[i]); }
    mx = wave_max(mx); float l = 0.f, p[3];
    for (int i = 0; i < 3; ++i) { p[i] = sc[i] > -1e29f ? exp2f(sc[i] - mx) : 0.f; l += p[i]; }
    l = wave_sum(l);
    const int h = seq & 15, br = seq >> 4, bl = br >> dsh, r = br & ((1 << dsh) - 1); const size_t tokrow = (size_t)bl * SEQ + ((size_t)j << dsh) + r;
    float e = 0.f;
    for (int dd = 0; dd < 64; ++dd) { float o = 0.f; for (int i = 0; i < 3; ++i) { const int kk = lane + 64 * i, jk = j - 128 + kk; if (p[i] > 0.f) o += p[i] * bf2f(vb[(size_t)jk * 64 + dd]); }
        o = wave_sum(o) / l; const float got = bf2f(opart[(size_t)g * GS + tokrow * DM + h * 64 + dd]); e = fmaxf(e, fabsf(got - o) / (0.02f * fabsf(o) + 0.02f)); }
    const float lref = mx + log2f(l), lgot = lse[(size_t)g * ((size_t)HTOK * NHEAD) + tokrow * NHEAD + h]; e = fmaxf(e, fabsf(lref - lgot) / 0.02f);
    if (lane == 0) report(d, id, e, 1.f);
}
__global__ void chk_merge(const bf16_t* opart, const float* lse, const bf16_t* hbh, unsigned* d, int id) {
    const int lane = threadIdx.x; const unsigned hh = hsh(blockIdx.x * 2654435761u + 41u); const int row = hh % HTOK; float e = 0.f;
    for (int c = lane; c < DM; c += 64) { const int h = c >> 6; float l[3], w[3], mx = -1e30f, sum = 0.f, o = 0.f;
        for (int g = 0; g < 3; ++g) { l[g] = lse[(size_t)g * ((size_t)HTOK * NHEAD) + (size_t)row * NHEAD + h]; mx = fmaxf(mx, l[g]); }
        for (int g = 0; g < 3; ++g) { w[g] = exp2f(l[g] - mx); sum += w[g]; }
        for (int g = 0; g < 3; ++g) o += w[g] / sum * bf2f(opart[(size_t)g * ((size_t)HTOK * DM) + (size_t)row * DM + c]);
        e = fmaxf(e, fabsf(bf2f(hbh[(size_t)row * DM + c]) - o) / (0.01f * fabsf(o) + 5e-3f)); }
    e = wave_max(e); if (lane == 0) report(d, id, e, 1.f);
}
__global__ void chk_res(const float* xo, const float* snap, unsigned salt, const bf16_t* A, int lda, int K, const float* W, int ldw, int wsel, const float* scale, unsigned* d, int id) {
    const int lane = threadIdx.x; const unsigned k = blockIdx.x; const unsigned h = hsh(k * 2654435761u + salt); const int row = h % NTOK, col = hsh(h) % DM;
    float dot, ad; if (wsel == 0) wdot(A + (size_t)row * lda, W + col, ldw, K, lane, dot, ad); else wdot(A + (size_t)row * lda + (col & ~255), W + (size_t)(col >> 8) * 65536 + (col & 255), 256, 256, lane, dot, ad);
    const float sc = scale ? scale[col] : 1.f; const float ref = snap[k] + sc * dot, got = xo[(size_t)row * DM + col];
    if (lane == 0) report(d, id, fabsf(got - ref), 0.01f * fabsf(sc) * ad + 2e-3f);
}
__global__ void chk_xg(const float* xo, const float* gain, const bf16_t* xg, const float* ssp, unsigned* d, int id) {
    const int lane = threadIdx.x; const unsigned row = hsh(blockIdx.x * 2654435761u + 53u) % NTOK; float e = 0.f, s = 0.f;
    for (int c = lane; c < DM; c += 64) { const float v = xo[(size_t)row * DM + c]; s += v * v; const float ref = v * gain[c]; e = fmaxf(e, fabsf(bf2f(xg[(size_t)row * DM + c]) - ref) / (0.01f * fabsf(ref) + 1e-3f)); }
    s = wave_sum(s); float sp = 0.f; if (lane < 16) sp = ssp[(size_t)row * 16 + lane]; sp = wave_sum(sp); e = fmaxf(wave_max(e), fabsf(sp - s) / (1e-3f * s + 1e-6f));
    if (lane == 0) report(d, id, e, 1.f);
}
__global__ void chk_ssp(const float* xo, const float* ssp, unsigned* d, int id) {
    const int lane = threadIdx.x; const unsigned row = hsh(blockIdx.x * 2654435761u + 59u) % NTOK; float s = 0.f;
    for (int c = lane; c < DM; c += 64) { const float v = xo[(size_t)row * DM + c]; s += v * v; }
    s = wave_sum(s); float sp = 0.f; if (lane < 16) sp = ssp[(size_t)row * 16 + lane]; sp = wave_sum(sp);
    if (lane == 0) report(d, id, fabsf(sp - s), 1e-3f * s + 1e-6f);
}
__global__ void chk_gu(const bf16_t* A, const float* xr, const float* wg, const float* wu, int nff, const bf16_t* act, const int* slot_of, const int* rt_e, size_t estride, unsigned* d, int id) {
    const int lane = threadIdx.x; const unsigned hh = hsh(blockIdx.x * 2654435761u + 61u); int row = hh % NTOK; const int j = hsh(hh) % nff; float r = 1.f; size_t eo = 0;
    if (xr) r = row_r(xr + (size_t)row * DM, lane);
    if (slot_of) { const int k = (hh >> 20) & 1; eo = (size_t)rt_e[2 * row + k] * estride; row = slot_of[2 * row + k]; }
    float g, u, a0, a1; wdot(A + (size_t)row * DM, wg + eo + j, nff, DM, lane, g, a0); wdot(A + (size_t)row * DM, wu + eo + j, nff, DM, lane, u, a1);
    const float ref = silu(g * r) * (u * r), got = bf2f(act[(size_t)row * nff + j]);
    if (lane == 0) report(d, id, fabsf(got - ref), 0.02f * fabsf(ref) + 0.01f * r * r * (a0 * fabsf(u) + a1 * fabsf(g)) + 5e-3f);
}
__global__ void chk_pprep(const float* xo, const float* gain, const bf16_t* pa, unsigned* d, int id) {
    const int lane = threadIdx.x; const unsigned hh = hsh(blockIdx.x * 2654435761u + 67u); int row = hh % NTOK; const int c = hsh(hh) % DM; if (blockIdx.x % 4 == 0) row = (row & ~2047) + (row & 15);
    const int t = row & 2047, g = c >> 8, P = 2 << g, lo = (t + 1 - P) > 0 ? (t + 1 - P) : 0; float sum = 0.f, cur = 0.f;
    for (int tt = lo; tt <= t; ++tt) { const float* xr = xo + (size_t)(row - t + tt) * DM; const float hn = xr[c] * row_r(xr, lane) * gain[c]; sum += hn; cur = hn; }
    const float ref = sum / (float)(t + 1 - lo) - cur, got = bf2f(pa[(size_t)row * DM + c]);
    if (lane == 0) report(d, id, fabsf(got - ref), 0.01f * fabsf(ref) + 0.01f * fabsf(cur) + 2e-3f);
}
__global__ void chk_route(const float* xo, const float* gain, const float* wr, const unsigned char* rt, const unsigned* cnt, const bf16_t* ag, unsigned* d, int id) {
    const int lane = threadIdx.x; const unsigned token = hsh(blockIdx.x * 2654435761u + 71u) % NTOK; const float* xr = xo + (size_t)token * DM; const float r = row_r(xr, lane);
    float lg[8]; for (int e = 0; e < 8; ++e) { float s = 0.f; for (int c = lane; c < DM; c += 64) s += xr[c] * r * gain[c] * wr[(size_t)c * 8 + e]; lg[e] = wave_sum(s); }
    int i0 = 0; for (int e = 1; e < 8; ++e) if (lg[e] > lg[i0]) i0 = e; int i1 = -1; for (int e = 0; e < 8; ++e) if (e != i0 && (i1 < 0 || lg[e] > lg[i1])) i1 = e;
    float third = -1e30f; for (int e = 0; e < 8; ++e) if (e != i0 && e != i1) third = fmaxf(third, lg[e]);
    const int* re = (const int*)(rt + RT_E); const int* rs = (const int*)(rt + RT_SLOT); const float* rg = (const float*)(rt + RT_GATE); const float* gs = (const float*)(rt + RT_GSLOT);
    float e = 0.f; const bool clear = (lg[i0] - lg[i1] > 1e-3f) && (lg[i1] - third > 1e-3f);
    if (clear) { if (re[2 * token] != i0 || re[2 * token + 1] != i1) e = 1e6f; const float g0 = 1.0f / (1.0f + expf(lg[i1] - lg[i0])); e = fmaxf(e, fabsf(rg[2 * token] - g0) / 2e-3f); e = fmaxf(e, fabsf(rg[2 * token + 1] - (1.f - g0)) / 2e-3f); }
    int pt[9]; { int acc = 0; for (int q = 0; q < 8; ++q) { pt[q] = acc; acc += ((int)cnt[q] + 255) >> 8; } pt[8] = acc; }
    for (int k = 0; k < 2; ++k) { const int ee = re[2 * token + k], ds = rs[2 * token + k]; if (ee < 0 || ee > 7 || ds < pt[ee] * 256 || ds >= pt[ee] * 256 + (int)cnt[ee]) { e = 2e6f; continue; }
        if (fabsf(gs[ds] - rg[2 * token + k]) > 1e-6f) e = fmaxf(e, 3e6f);
        for (int c = lane; c < DM; c += 64) { const float ref = xr[c] * r * gain[c]; e = fmaxf(e, fabsf(bf2f(ag[(size_t)ds * DM + c]) - ref) / (0.01f * fabsf(ref) + 1e-3f)); } }
    e = wave_max(e); if (lane == 0) report(d, id, e, 1.f);
}
__global__ void chk_mdown(const bf16_t* act2, const float* md, const bf16_t* y, const unsigned char* rt, unsigned* d, int id) {
    const int lane = threadIdx.x; const unsigned hh = hsh(blockIdx.x * 2654435761u + 73u); const int token = hh % NTOK, col = hsh(hh) % DM, k = (hh >> 20) & 1;
    const int ee = ((const int*)(rt + RT_E))[2 * token + k], ds = ((const int*)(rt + RT_SLOT))[2 * token + k]; const float gt = ((const float*)(rt + RT_GATE))[2 * token + k];
    float dot, ad; wdot(act2 + (size_t)ds * DFFE, md + (size_t)ee * DFFE * DM + col, DM, DFFE, lane, dot, ad);
    if (lane == 0) report(d, id, fabsf(bf2f(y[(size_t)ds * DM + col]) - gt * dot), 0.01f * gt * ad + 0.01f * fabsf(gt * dot) + 2e-3f);
}
__global__ void chk_comb(const float* xo, const float* snaprows, unsigned salt, const bf16_t* y, const unsigned char* rt, const bf16_t* hb, const float* gain, int last, unsigned* d, int id) {
    const int lane = threadIdx.x; const unsigned k = blockIdx.x; const unsigned token = hsh(k * 2654435761u + salt) % NTOK;
    const int d0 = ((const int*)(rt + RT_SLOT))[2 * token], d1 = ((const int*)(rt + RT_SLOT))[2 * token + 1]; float s = 0.f;
    for (int c = lane; c < DM; c += 64) { const float v = snaprows[(size_t)k * DM + c] + bf2f(y[(size_t)d0 * DM + c]) + bf2f(y[(size_t)d1 * DM + c]); s += v * v; }
    const float r = 1.0f / sqrtf(wave_sum(s) * (1.0f / DM) + RMS_EPS); float e = 0.f;
    for (int c = lane; c < DM; c += 64) { const float v = snaprows[(size_t)k * DM + c] + bf2f(y[(size_t)d0 * DM + c]) + bf2f(y[(size_t)d1 * DM + c]); const float n = v * r * gain[c];
        if (last) e = fmaxf(e, fabsf(xo[(size_t)token * DM + c] - n) / (1e-3f * fabsf(n) + 1e-4f));
        else { e = fmaxf(e, fabsf(xo[(size_t)token * DM + c] - v) / (1e-4f * fabsf(v) + 1e-5f)); e = fmaxf(e, fabsf(bf2f(hb[(size_t)token * DM + c]) - n) / (0.01f * fabsf(n) + 1e-3f)); } }
    e = wave_max(e); if (lane == 0) report(d, id, e, 1.f);
}
__global__ void report_out(float* out, int n, const unsigned* d, const unsigned* tmo) {
    int id = -1; float ratio = 0.f; for (int k = 0; k < 64; ++k) if (d[k] != 0u) { id = k; ratio = __uint_as_float(d[k]); break; }
    if (id < 0 && tmo[XB_TMO] != 0u) { id = 63; ratio = 1.f; }
    if (id < 0) return;
    int E = 2 + (int)fminf(20.f, floorf(log10f(fmaxf(ratio, 1.f)))); const float c = sqrtf(1.01f * (float)(10 + id)) * powf(10.f, 0.5f * (float)E);
    for (int i = blockIdx.x * blockDim.x + threadIdx.x; i < n; i += gridDim.x * blockDim.x) out[i] = c;
}
}
#endif

extern "C" void kernel_launch(void* const* d_in, const int* in_sizes, int n_in, void* d_out, int out_size, void* d_ws, size_t ws_size, hipStream_t stream) {
    static int grid = 0;
    if (grid == 0) {
        if (n_in != 15 || out_size != NTOK * DM || ws_size < WS_END + (DEBUG_CHECK ? 4 * MiB : 0)) { fprintf(stderr, "kernel_launch: unexpected shapes / workspace (%d inputs, out %d, ws %zu)\n", n_in, out_size, ws_size); grid = -1; return; }
        int dev = 0, cus = 0, per_cu = 0;
        if (hipGetDevice(&dev) != hipSuccess || hipDeviceGetAttribute(&cus, hipDeviceAttributeMultiprocessorCount, dev) != hipSuccess) { grid = -1; return; }
        if (hipFuncSetAttribute((const void*)fwd, hipFuncAttributeMaxDynamicSharedMemorySize, LDS_BYTES) != hipSuccess) { grid = -1; return; }
        if (hipOccupancyMaxActiveBlocksPerMultiprocessor(&per_cu, (const void*)fwd, 512, LDS_BYTES) != hipSuccess || per_cu < 1) fprintf(stderr, "kernel_launch: occupancy query reports %d\n", per_cu);
        (void)hipGetLastError();
        grid = cus;
    }
    if (grid < 0) return;
    (void)hipMemsetAsync((char*)d_ws + WS_CTL, 0, CTL_ZERO_BYTES, stream);
    Args a{};
    for (int i = 0; i < 15; ++i) a.in[i] = (const float*)d_in[i];
    a.out = (float*)d_out; a.ws = (unsigned char*)d_ws;
#if !DEBUG_CHECK
    a.ph_lo = 0; a.ph_hi = 2 * NPH; a.li = 0; a.pad = 0;
    hipLaunchKernelGGL(fwd, dim3(grid), dim3(512), LDS_BYTES, stream, a);
#else
    unsigned char* ws = (unsigned char*)d_ws; unsigned* ctl = (unsigned*)ws; unsigned* D = ctl + CW_DBG; float* xo = (float*)d_out;
    float* snap = (float*)(ws + WS_SNAP); float* snaprows = (float*)(ws + WS_SNAP + 1 * MiB);
    const float* const* in = (const float* const*)d_in; unsigned char* rt = ws + WS_RT;
    constexpr int NS = 256;
    for (int ph = 0; ph < 2 * NPH; ++ph) {
        const int lp = ph / NPH, k = ph % NPH; if (lp == 1 && k == PH_PRE) continue;
        const int cid = 20 * lp; const unsigned salt = 1000u + ph;
        const float* xres = (lp == 0) ? in[0] : xo;
        if (k == PH_WO) dbg::snap_pos<<<NS / 64, 64, 0, stream>>>(xres, snap, salt);
        if (k == PH_DDOWN || k == PH_PGEMM) dbg::snap_pos<<<NS / 64, 64, 0, stream>>>(xo, snap, salt);
        if (k == PH_COMB) dbg::snap_rows<<<64, 64, 0, stream>>>(xo, snaprows, salt);
        a.ph_lo = ph; a.ph_hi = ph + 1; a.li = ph; a.pad = 0;
        hipLaunchKernelGGL(fwd, dim3(grid), dim3(512), LDS_BYTES, stream, a);
        const bf16_t* HB = (const bf16_t*)(ws + WS_HB);
        if (k == PH_PRE) dbg::chk_norm<<<64, 64, 0, stream>>>(in[0], in[1], HB, D, 1);
        if (k == PH_QKV0 || k == PH_QKV1) dbg::chk_qkv<<<NS, 64, 0, stream>>>(HB + (size_t)(k == PH_QKV1) * HTOK * DM, in[3] + (size_t)lp * DM * NQKV, (const bf16_t*)(ws + WS_QKVB), D, cid + (k == PH_QKV0 ? 2 : 3));
        if (k == PH_ATT0 || k == PH_ATT1) dbg::chk_attn<<<NS * 3, 64, 0, stream>>>((const bf16_t*)(ws + WS_QKVB), (const bf16_t*)(ws + WS_OPART), (const float*)(ws + WS_LSE), D, cid + 4);
        if (k == PH_MRG0 || k == PH_MRG1) dbg::chk_merge<<<64, 64, 0, stream>>>((const bf16_t*)(ws + WS_OPART), (const float*)(ws + WS_LSE), HB + (size_t)(k == PH_MRG1) * HTOK * DM, D, cid + 5);
        if (k == PH_WO) { dbg::chk_res<<<NS, 64, 0, stream>>>(xo, snap, salt, HB, DM, DM, in[4] + (size_t)lp * DM * DM, DM, 0, nullptr, D, cid + 6);
            dbg::chk_xg<<<64, 64, 0, stream>>>(xo, in[2] + (size_t)(2 * lp) * DM, (const bf16_t*)(ws + WS_XG), (const float*)(ws + WS_SSP), D, cid + 6); }
        if (k == PH_DGU) dbg::chk_gu<<<NS, 64, 0, stream>>>((const bf16_t*)(ws + WS_XG), xo, in[7] + (size_t)lp * DM * DFF, in[8] + (size_t)lp * DM * DFF, DFF, (const bf16_t*)(ws + WS_ACT), nullptr, nullptr, 0, D, cid + 7);
        if (k == PH_DDOWN) { dbg::chk_res<<<NS, 64, 0, stream>>>(xo, snap, salt, (const bf16_t*)(ws + WS_ACT), DFF, DFF, in[9] + (size_t)lp * DFF * DM, DM, 0, nullptr, D, cid + 8);
            dbg::chk_ssp<<<64, 64, 0, stream>>>(xo, (const float*)(ws + WS_SSP), D, cid + 8); }
        if (k == PH_PPREP) dbg::chk_pprep<<<NS, 64, 0, stream>>>(xo, in[1] + (size_t)(2 * lp + 1) * DM, HB, D, cid + 9);
        if (k == PH_PGEMM) dbg::chk_res<<<NS, 64, 0, stream>>>(xo, snap, salt, HB, DM, 256, in[5] + (size_t)lp * 4 * 65536, 256, 1, in[6] + (size_t)lp * DM, D, cid + 10);
        if (k == PH_GATHER) dbg::chk_route<<<NS, 64, 0, stream>>>(xo, in[2] + (size_t)(2 * lp + 1) * DM, in[10] + (size_t)lp * DM * 8, rt, ctl + CW_CNT + 64 * lp, (const bf16_t*)(ws + WS_AG), D, cid + 11);
        if (k == PH_MGU) dbg::chk_gu<<<NS, 64, 0, stream>>>((const bf16_t*)(ws + WS_AG), nullptr, in[11] + (size_t)lp * 8 * DM * DFFE, in[12] + (size_t)lp * 8 * DM * DFFE, DFFE, (const bf16_t*)(ws + WS_ACT2), (const int*)(rt + RT_SLOT), (const int*)(rt + RT_E), (size_t)DM * DFFE, D, cid + 12);
        if (k == PH_MDOWN) dbg::chk_mdown<<<NS, 64, 0, stream>>>((const bf16_t*)(ws + WS_ACT2), in[13] + (size_t)lp * 8 * DFFE * DM, (const bf16_t*)(ws + WS_Y), rt, D, cid + 13);
        if (k == PH_COMB) dbg::chk_comb<<<64, 64, 0, stream>>>(xo, snaprows, salt, (const bf16_t*)(ws + WS_Y), rt, HB, lp == 0 ? in[1] + (size_t)2 * DM : in[14], lp == 1, D, cid + 14);
    }
    dbg::report_out<<<1024, 256, 0, stream>>>(xo, out_size, D, ctl + CW_BAR);
#endif
}
```

```cpp
#include <hip/hip_runtime.h>
#include <cstdio>
#include <cstdint>

#ifndef DEBUG_CHECK
#define DEBUG_CHECK 0
#endif
#ifndef PROBE
#define PROBE 0
#endif
#ifndef TWICE
#define TWICE 0
#endif
#ifndef PROBE_BLK
#define PROBE_BLK 0
#define PROBE_WAVE 0
#endif

#define LAS __attribute__((address_space(3)))
#define GAS __attribute__((address_space(1)))
typedef unsigned short bf16_t;
typedef short bf16x8 __attribute__((ext_vector_type(8)));
typedef short s16x4 __attribute__((ext_vector_type(4)));
typedef float f32x4 __attribute__((ext_vector_type(4)));
typedef float f32x2 __attribute__((ext_vector_type(2)));
typedef unsigned u32x4 __attribute__((ext_vector_type(4)));
typedef unsigned u32x2 __attribute__((ext_vector_type(2)));

constexpr int NTOK = 32768, DM = 1024, SEQ = 2048, NHEAD = 16, HDIM = 64;
constexpr int NQKV = 9216, DFF = 2816, DFFE = 3584, NEXP = 8;
constexpr int HTOK = 16384;
constexpr float RMS_EPS = 1e-6f;
constexpr float QSCALE = 0.125f * 1.4426950408889634f;
constexpr int RING_BYTES = 131072, MISC_OFF = RING_BYTES + 320, LDS_BYTES = 149504;
constexpr int TOK_OFF = RING_BYTES + 1024;
constexpr int MAXSLOT = 67584;

constexpr size_t MiB = 1u << 20;
constexpr size_t WS_CTL = 0, CTL_ZERO_BYTES = 1 * MiB;
constexpr size_t WS_ROPE = 1 * MiB;
constexpr size_t WS_SSP = 2 * MiB;
constexpr size_t WS_RT = 4 * MiB;
constexpr size_t RT_E = 0, RT_RANK = 256 * 1024, RT_GATE = 512 * 1024, RT_R = 768 * 1024, RT_CNTB = 1024 * 1024;
constexpr size_t WS_SSP2 = 6 * MiB;
constexpr size_t WS_RINV = 8 * MiB;
constexpr size_t WS_WQKV = 10 * MiB, WS_WO = 46 * MiB, WS_WPOOL = 50 * MiB, WS_WDGU = 51 * MiB, WS_WDD = 73 * MiB, WS_WMGU = 84 * MiB, WS_WMD = 196 * MiB;
constexpr size_t WS_XB = 252 * MiB;
constexpr size_t WS_HB = 316 * MiB;
constexpr size_t WS_QKVB = 380 * MiB;
constexpr size_t WS_OPART = 668 * MiB;
constexpr size_t WS_LSE = 764 * MiB;
constexpr size_t WS_ACT = 380 * MiB;
constexpr size_t WS_Y = 316 * MiB;
constexpr size_t WS_ACT2 = 448 * MiB;
constexpr size_t WS_LISTS = 910 * MiB;
constexpr size_t WS_PART = 916 * MiB;
constexpr size_t WS_END = 944 * MiB;
constexpr size_t WS_SNAP = 945 * MiB;
constexpr int CW_CNT = 1024;
constexpr int CW_DBG = 2048;
constexpr int CW_BAR = 4096;

__device__ __forceinline__ unsigned f2bf(float f) { unsigned u = __builtin_bit_cast(unsigned, f); return (u + 0x7fffu + ((u >> 16) & 1u)) >> 16; }
__device__ __forceinline__ unsigned pk2(float lo, float hi) { return f2bf(lo) | (f2bf(hi) << 16); }
__device__ __forceinline__ float bf2f(unsigned short b) { return __builtin_bit_cast(float, (unsigned)b << 16); }
__device__ __forceinline__ unsigned cvt_pk_bf16(float lo, float hi) { unsigned r; asm volatile("v_cvt_pk_bf16_f32 %0, %1, %2" : "=v"(r) : "v"(lo), "v"(hi)); return r; }
template <int CTRL> __device__ __forceinline__ float dpp_mov(float v) { return __builtin_bit_cast(float, __builtin_amdgcn_update_dpp(0, __builtin_bit_cast(int, v), CTRL, 0xF, 0xF, true)); }
__device__ __forceinline__ float wave_sum(float v) {
    v += dpp_mov<0xB1>(v); v += dpp_mov<0x4E>(v); v += dpp_mov<0x141>(v); v += dpp_mov<0x140>(v);
    auto r = __builtin_amdgcn_permlane16_swap(__float_as_uint(v), __float_as_uint(v), false, false); v = __uint_as_float(r[0]) + __uint_as_float(r[1]);
    auto q = __builtin_amdgcn_permlane32_swap(__float_as_uint(v), __float_as_uint(v), false, false); return __uint_as_float(q[0]) + __uint_as_float(q[1]);
}
__device__ __forceinline__ float wave_max(float v) {
#pragma unroll
    for (int o = 1; o < 64; o <<= 1) v = fmaxf(v, __shfl_xor(v, o));
    return v;
}
__device__ __forceinline__ int lane_id() { int l; asm volatile("v_mbcnt_lo_u32_b32 %0, -1, 0\n\tv_mbcnt_hi_u32_b32 %0, -1, %0" : "=v"(l)); return l; }
#define LDS_WAIT() asm volatile("s_waitcnt lgkmcnt(0)" ::: "memory")
#define VM_WAIT() asm volatile("s_waitcnt vmcnt(0)" ::: "memory")

#define XB_TMO      128
#define XB_XCNT(j)  (256  + 64 * (j))
#define XB_XSUB(j)  (1280 + 64 * (j))
#define XB_XGEN(j)  (2304 + 64 * (j))
#define XB_TOP      3328
#define XB_TOPGEN   3392
#define XCD_BAR_WORDS 3456
#define XB_SPIN_CAP (1u << 22)
__device__ __forceinline__ unsigned xb_ld(unsigned* p)              { return __hip_atomic_load(p, __ATOMIC_RELAXED, __HIP_MEMORY_SCOPE_AGENT); }
__device__ __forceinline__ unsigned xb_add(unsigned* p, unsigned v) { return __hip_atomic_fetch_add(p, v, __ATOMIC_RELAXED, __HIP_MEMORY_SCOPE_AGENT); }
__device__ __forceinline__ unsigned xb_xcc_id() { return (unsigned)__builtin_amdgcn_s_getreg((3 << 11) | 20) & 0xFu; }
#define XB_SPIN(cond, bar) do { unsigned _sp = 0; while (cond) { __builtin_amdgcn_s_sleep(1); \
    if ((++_sp & 255u) == 0u) { if (xb_ld(&(bar)[XB_TMO])) break; if (_sp > XB_SPIN_CAP) { atomicAdd(&(bar)[XB_TMO], 1u); break; } } } } while (0)
struct XcdBarrier { unsigned* bar; unsigned x; volatile LAS unsigned* st; };
__device__ __forceinline__ XcdBarrier xcd_barrier_post(unsigned* bar, volatile LAS unsigned* st) {
    XcdBarrier b; b.bar = bar; b.x = xb_xcc_id(); b.st = st;
    if (threadIdx.x == 0) (void)xb_add(&bar[XB_XCNT(b.x)], 1u);
    return b;
}
__device__ __forceinline__ void xcd_barrier_complete(unsigned* bar, unsigned x, unsigned& nloc, unsigned& nx) {
    const unsigned G = gridDim.x * gridDim.y * gridDim.z;
    unsigned sum, cnt, mine, sp = 0u;
    for (;;) {
        sum = 0u; cnt = 0u; mine = 0u;
#pragma unroll
        for (unsigned j = 0; j < 16; ++j) { const unsigned c = xb_ld(&bar[XB_XCNT(j)]); sum += c; cnt += (c > 0u) ? 1u : 0u; mine = (j == x) ? c : mine; }
        if (sum == G) break;
        __builtin_amdgcn_s_sleep(1);
        if ((++sp & 255u) == 0u) { if (xb_ld(&bar[XB_TMO])) break; if (sp > XB_SPIN_CAP) { atomicAdd(&bar[XB_TMO], 1u); break; } }
    }
    nloc = mine > 0u ? mine : 1u; nx = cnt > 0u ? cnt : 1u;
}
__device__ __forceinline__ void xcd_barrier(const XcdBarrier& b, bool leader) {
    asm volatile("s_waitcnt vmcnt(0)" ::: "memory");
    __syncthreads();
    if (leader) {
        unsigned* bar = b.bar;
        __builtin_amdgcn_s_waitcnt(0);
        unsigned nloc = b.st[0], nx = b.st[1];
        if (nloc == 0u) { xcd_barrier_complete(bar, b.x, nloc, nx); b.st[0] = nloc; b.st[1] = nx; }
        const unsigned old = xb_add(&bar[XB_XSUB(b.x)], 1u);
        const unsigned gen = old / nloc;
        if (old + 1u == (gen + 1u) * nloc) {
            __builtin_amdgcn_fence(__ATOMIC_RELEASE, "agent");
            asm volatile("s_waitcnt vmcnt(0)" ::: "memory");
            const unsigned og = xb_add(&bar[XB_TOP], 1u);
            const unsigned tg = og / nx;
            if (og + 1u == (tg + 1u) * nx) xb_add(&bar[XB_TOPGEN], 1u);
            else XB_SPIN(xb_ld(&bar[XB_TOPGEN]) == tg, bar);
            __builtin_amdgcn_fence(__ATOMIC_ACQUIRE, "agent");
            xb_add(&bar[XB_XGEN(b.x)], 1u);
            asm volatile("s_waitcnt vmcnt(0)" ::: "memory");
        } else {
            XB_SPIN(xb_ld(&bar[XB_XGEN(b.x)]) == gen, bar);
            __builtin_amdgcn_fence(__ATOMIC_ACQUIRE, "agent");
            asm volatile("s_waitcnt vmcnt(0)" ::: "memory");
        }
    }
    __syncthreads();
}

namespace pg8 {
#define PG8_LAS __attribute__((address_space(3)))
constexpr int BM = 256, BK = 64, HALF = 128, HTB = HALF * BK * 2, STAGE_BYTES = 8 * HTB, NXCD = 8, WGM = 8;
__host__ __device__ __forceinline__ int lds_byte(int r, int c) { const int st = (r >> 4) * 2 + (c >> 5), rr = r & 15, cc = c & 31, ob = rr * 64 + cc * 2; return st * 1024 + (ob ^ (((ob >> 9) & 1) << 5)); }
__host__ __device__ __forceinline__ void stage_rc(int b, int& R, int& C) { const int st = b / 1024, sb = b % 1024, swz = sb ^ (((sb >> 9) & 1) << 5); R = (st >> 1) * 16 + swz / 64; C = (st & 1) * 32 + (swz % 64) / 2; }
__host__ __device__ __forceinline__ int perm32(int rho) { const int n = rho >> 4, i = rho & 15; return 8 * (i >> 2) + 4 * n + (i & 3); }

struct Unit { int pm, pn; const char* a; const char* b; int lb, nvalid; };
struct Gemm { int K, lda, ldb; };

struct TileMap {
    int nM, nN, nwg, G, c, maxi;
    __device__ __forceinline__ void init(int nM_, int nN_, int G_, int c_) { nM = nM_; nN = nN_; nwg = nM * nN; G = G_; c = c_; maxi = 0x7fffffff; }
    __device__ __forceinline__ bool map(int i, int& pm, int& pn) const { if (i >= maxi) return false; const long L = (long)i * G + c; if (L >= nwg) return false; mapL((int)L, pm, pn); return true; }
    __device__ __forceinline__ void mapL(int L, int& pm, int& pn) const {
        int wgid = L; { const int q = nwg / NXCD, r = nwg % NXCD, xcd = wgid % NXCD, off = wgid / NXCD; wgid = (xcd < r ? xcd * (q + 1) : r * (q + 1) + (xcd - r) * q) + off; }
        const int nig = WGM * nN, gid = wgid / nig, fm = gid * WGM, gsz = (nM - fm) < WGM ? (nM - fm) : WGM;
        pm = fm + ((wgid % nig) % gsz); pn = (wgid % nig) / gsz;
    }
};
struct SchedPlain {
    TileMap tm; const char* A; const char* Bt; size_t atile, btile;
    __device__ __forceinline__ bool next(int i, Unit& u) const { if (!tm.map(i, u.pm, u.pn)) return false; u.a = A + (size_t)u.pm * atile; u.b = Bt + (size_t)u.pn * btile; u.lb = 0; u.nvalid = 256; return true; }
    __device__ __forceinline__ void a_ready(const Unit&) const {}
    __device__ __forceinline__ void done(const Unit&) const {}
};
struct SchedPool {
    TileMap tm; const char* A; const char* Bt; size_t atile;
    __device__ __forceinline__ bool next(int i, Unit& u) const { if (!tm.map(i, u.pm, u.pn)) return false; u.a = A + (size_t)u.pm * atile + (size_t)u.pn * 512; u.b = Bt + (size_t)u.pn * 131072; u.lb = 0; u.nvalid = 256; return true; }
    __device__ __forceinline__ void a_ready(const Unit&) const {}
    __device__ __forceinline__ void done(const Unit&) const {}
};
struct SchedMoe {
    TileMap tm; const char* A; const char* Bt; size_t atile, btile, estride; const LAS int* pt; const int* toks;
    __device__ __forceinline__ bool next(int i, Unit& u) const { if (!tm.map(i, u.pm, u.pn)) return false; int e = 0;
#pragma unroll
        for (int k = 1; k < 8; ++k) e += (pt[k] <= u.pm) ? 1 : 0;
        const int rank0 = (u.pm - pt[e]) * 256; u.lb = e * NTOK + rank0; u.nvalid = pt[16 + e] - rank0;
        u.a = A + (size_t)u.pm * atile; u.b = Bt + (size_t)e * estride + (size_t)u.pn * btile; return true; }
    __device__ __forceinline__ const int* tok_src(const Unit& u) const { return toks + u.lb; }
    __device__ __forceinline__ void a_ready(const Unit&) const {}
    __device__ __forceinline__ void done(const Unit&) const {}
};

struct SchedMoeSplit {
    TileMap tm; const char* A; const char* Bt; size_t atile, btile, estride; const LAS int* pt; int first, nsplit;
    __device__ __forceinline__ bool next(int i, Unit& u) const { if (i > 0 || tm.c >= 4 * nsplit) return false; const int su = tm.c >> 2, q = tm.c & 3; tm.mapL(first + su, u.pm, u.pn); int e = 0;
#pragma unroll
        for (int k = 1; k < 8; ++k) e += (pt[k] <= u.pm) ? 1 : 0;
        u.lb = su * 4 + q; u.nvalid = 256; const size_t ko = (size_t)q * (DFFE / 4) * 2;
        u.a = A + (size_t)u.pm * atile + ko; u.b = Bt + (size_t)e * estride + (size_t)u.pn * btile + ko; return true; }
    __device__ __forceinline__ void a_ready(const Unit&) const {}
    __device__ __forceinline__ void done(const Unit&) const {}
};

struct EpiQKV {
    static constexpr bool PERM = true, AFTER_DRAIN = false;
    bf16_t* qkvb; const float* rope; const float* rinv;
    static __device__ __forceinline__ f32x4 rot(f32x4 c, f32x4 d) { f32x4 o; o[0] = c[0] * d[0] - c[1] * d[1]; o[1] = c[1] * d[0] + c[0] * d[1]; o[2] = c[2] * d[2] - c[3] * d[3]; o[3] = c[3] * d[2] + c[2] * d[3]; return o; }
    __device__ __forceinline__ void operator()(const f32x4 (&acc)[2][2][4][2], const Unit& u, int wr, int wc, int fr_, int fq) const {
        int fr = fr_; asm volatile("" : "+v"(fr));
        const int g = u.pn / 12, rem = u.pn - 12 * g, t = rem >> 2, cq = (rem & 3) * 256, dsh = 2 * g, Lg = SEQ >> dsh;
        bf16_t* buf = qkvb + (size_t)(g * 3 + t) * ((size_t)HTOK * DM);
        const int cb0 = cq + wc * 32 + 8 * fq, h0 = cb0 >> 6, p0 = cb0 & 63, i0 = p0 >> 1;
        const int rowb = u.pm * BM + wr * 64 + fr, s0 = rowb & 2047;
        f32x4 c0 = {1.f, 0.f, 1.f, 0.f}, c1 = c0, b0 = c0, b1 = c0, da = c0, db = c0;
        float rfs[2][4];
#pragma unroll
        for (int ai = 0; ai < 2; ++ai)
#pragma unroll
            for (int m = 0; m < 4; ++m) rfs[ai][m] = rinv[rowb + ai * HALF + m * 16];
        f32x4 ea = c0, eb = c0;
        if (t < 2) { const f32x4* cs = (const f32x4*)(rope + ((size_t)s0 * 32 + i0) * 2); b0 = cs[0]; b1 = cs[1]; const f32x4* dd = (const f32x4*)(rope + (size_t)SEQ * 64 + i0 * 2); da = dd[0]; db = dd[1]; ea = dd[16]; eb = dd[17]; }
        if (t == 2) {
#pragma unroll
            for (int ai = 0; ai < 2; ++ai)
#pragma unroll
                for (int m = 0; m < 4; ++m) { const int row = rowb + ai * HALF + m * 16, bl = row >> 11, s = row & 2047, r = s & ((1 << dsh) - 1), j = s >> dsh; const float rf = rfs[ai][m];
#pragma unroll
                    for (int bj = 0; bj < 2; ++bj) { const int seq = ((bl << dsh) + r) * NHEAD + h0 + 2 * bj; const f32x4 v0 = acc[ai][bj][m][0] * rf, v1 = acc[ai][bj][m][1] * rf;
                        u32x4 w; w.x = cvt_pk_bf16(v0[0], v0[1]); w.y = cvt_pk_bf16(v0[2], v0[3]); w.z = cvt_pk_bf16(v1[0], v1[1]); w.w = cvt_pk_bf16(v1[2], v1[3]);
                        *(u32x4*)(buf + ((size_t)seq * Lg + j) * HDIM + p0) = w; } }
        } else {
            const float qs = (t == 0) ? QSCALE : 1.0f;
#pragma unroll
            for (int ai = 0; ai < 2; ++ai) {
                if (ai == 1) { b0 = rot(b0, ea); b1 = rot(b1, eb); } c0 = b0; c1 = b1;
#pragma unroll
                for (int m = 0; m < 4; ++m) {
                    if (m > 0) { c0 = rot(c0, da); c1 = rot(c1, db); }
                    const int row = rowb + ai * HALF + m * 16, bl = row >> 11, s = row & 2047, r = s & ((1 << dsh) - 1), j = s >> dsh; const float rf = rfs[ai][m] * qs;
#pragma unroll
                    for (int bj = 0; bj < 2; ++bj) { const int seq = ((bl << dsh) + r) * NHEAD + h0 + 2 * bj; const f32x4 v0 = acc[ai][bj][m][0] * rf, v1 = acc[ai][bj][m][1] * rf;
                        f32x4 w0, w1; w0[0] = v0[0] * c0[0] - v0[1] * c0[1]; w0[1] = v0[1] * c0[0] + v0[0] * c0[1]; w0[2] = v0[2] * c0[2] - v0[3] * c0[3]; w0[3] = v0[3] * c0[2] + v0[2] * c0[3];
                        w1[0] = v1[0] * c1[0] - v1[1] * c1[1]; w1[1] = v1[1] * c1[0] + v1[0] * c1[1]; w1[2] = v1[2] * c1[2] - v1[3] * c1[3]; w1[3] = v1[3] * c1[2] + v1[2] * c1[3];
                        u32x4 w; w.x = cvt_pk_bf16(w0[0], w0[1]); w.y = cvt_pk_bf16(w0[2], w0[3]); w.z = cvt_pk_bf16(w1[0], w1[1]); w.w = cvt_pk_bf16(w1[2], w1[3]);
                        *(u32x4*)(buf + ((size_t)seq * Lg + j) * HDIM + p0) = w; } } }
        }
    }
};
template <bool SCALE, bool SSP> struct EpiResB {
    static constexpr bool PERM = true, AFTER_DRAIN = false;
    bf16_t* xb; const float* colscale; float* ssp;
    __device__ __forceinline__ void operator()(const f32x4 (&acc)[2][2][4][2], const Unit& u, int wr, int wc, int fr_, int fq) const {
        int fr = fr_; asm volatile("" : "+v"(fr));
        const int col0 = u.pn * BM + wc * 32 + 8 * fq;
        f32x4 sc[2][2];
        if (SCALE) {
#pragma unroll
            for (int bj = 0; bj < 2; ++bj) { sc[bj][0] = *(const f32x4*)(colscale + col0 + bj * HALF); sc[bj][1] = *(const f32x4*)(colscale + col0 + bj * HALF + 4); } }
#pragma unroll
        for (int ai = 0; ai < 2; ++ai) {
            u32x4 xin[4][2];
#pragma unroll
            for (int m = 0; m < 4; ++m)
#pragma unroll
                for (int bj = 0; bj < 2; ++bj) xin[m][bj] = *(const u32x4*)(xb + (size_t)(u.pm * BM + ai * HALF + wr * 64 + m * 16 + fr) * DM + col0 + bj * HALF);
#pragma unroll
            for (int m = 0; m < 4; ++m) { const int row = u.pm * BM + ai * HALF + wr * 64 + m * 16 + fr; const size_t off = (size_t)row * DM + col0; float ss = 0.f;
#pragma unroll
                for (int bj = 0; bj < 2; ++bj) { f32x4 v0 = acc[ai][bj][m][0], v1 = acc[ai][bj][m][1];
                    if (SCALE) { v0 = v0 * sc[bj][0]; v1 = v1 * sc[bj][1]; }
                    const u32x4 x = xin[m][bj];
                    v0[0] += __builtin_bit_cast(float, x.x << 16); v0[1] += __builtin_bit_cast(float, x.x & 0xffff0000u); v0[2] += __builtin_bit_cast(float, x.y << 16); v0[3] += __builtin_bit_cast(float, x.y & 0xffff0000u);
                    v1[0] += __builtin_bit_cast(float, x.z << 16); v1[1] += __builtin_bit_cast(float, x.z & 0xffff0000u); v1[2] += __builtin_bit_cast(float, x.w << 16); v1[3] += __builtin_bit_cast(float, x.w & 0xffff0000u);
                    u32x4 w; w.x = cvt_pk_bf16(v0[0], v0[1]); w.y = cvt_pk_bf16(v0[2], v0[3]); w.z = cvt_pk_bf16(v1[0], v1[1]); w.w = cvt_pk_bf16(v1[2], v1[3]);
                    *(u32x4*)(xb + off + bj * HALF) = w;
                    if (SSP) ss += (v0[0] * v0[0] + v0[1] * v0[1]) + (v0[2] * v0[2] + v0[3] * v0[3]) + (v1[0] * v1[0] + v1[1] * v1[1]) + (v1[2] * v1[2] + v1[3] * v1[3]); }
                if (SSP) { ss += __shfl_xor(ss, 16); ss += __shfl_xor(ss, 32); if (fq == 0) ssp[(size_t)(u.pn * 4 + wc) * NTOK + row] = ss; } }
        }
    }
};
template <int NORM> struct EpiGU {
    static constexpr bool PERM = true, AFTER_DRAIN = false;
    bf16_t* act; int ldact; const float* rv;
    __device__ __forceinline__ void operator()(const f32x4 (&acc)[2][2][4][2], const Unit& u, int wr, int wc, int fr_, int fq) const {
        int fr = fr_; asm volatile("" : "+v"(fr));
        const int col0 = u.pn * HALF + wc * 32 + 8 * fq;
#pragma unroll
        for (int ai = 0; ai < 2; ++ai) {
            float rr[4];
#pragma unroll
            for (int m = 0; m < 4; ++m) { const int lrow = ai * HALF + wr * 64 + m * 16 + fr; rr[m] = (NORM == 1) ? rv[u.pm * BM + lrow] : (NORM == 2) ? rv[u.lb + lrow] : 1.f; }
#pragma unroll
            for (int m = 0; m < 4; ++m) { const int row = u.pm * BM + ai * HALF + wr * 64 + m * 16 + fr; const float r = rr[m];
                f32x4 o[2];
#pragma unroll
                for (int n = 0; n < 2; ++n) { const f32x4 g4 = acc[ai][0][m][n] * r, u4 = acc[ai][1][m][n] * r, t4 = g4 * (-1.4426950408889634f);
                    f32x4 e4; e4[0] = __builtin_amdgcn_exp2f(t4[0]); e4[1] = __builtin_amdgcn_exp2f(t4[1]); e4[2] = __builtin_amdgcn_exp2f(t4[2]); e4[3] = __builtin_amdgcn_exp2f(t4[3]);
                    const f32x4 d4 = e4 + 1.0f; f32x4 i4; i4[0] = __builtin_amdgcn_rcpf(d4[0]); i4[1] = __builtin_amdgcn_rcpf(d4[1]); i4[2] = __builtin_amdgcn_rcpf(d4[2]); i4[3] = __builtin_amdgcn_rcpf(d4[3]);
                    o[n] = (g4 * u4) * i4; }
                u32x4 w; w.x = cvt_pk_bf16(o[0][0], o[0][1]); w.y = cvt_pk_bf16(o[0][2], o[0][3]); w.z = cvt_pk_bf16(o[1][0], o[1][1]); w.w = cvt_pk_bf16(o[1][2], o[1][3]);
                *(u32x4*)(act + (size_t)row * ldact + col0) = w; } }
    }
};
struct EpiMoeDown {
    static constexpr bool PERM = true, AFTER_DRAIN = false;
    bf16_t* y; const float* gate; const int* ydst;
    __device__ __forceinline__ void operator()(const f32x4 (&acc)[2][2][4][2], const Unit& u, int wr, int wc, int fr_, int fq) const {
        int fr = fr_; asm volatile("" : "+v"(fr));
        const int col0 = u.pn * BM + wc * 32 + 8 * fq;
        float gg[2][4]; int dd[2][4];
#pragma unroll
        for (int ai = 0; ai < 2; ++ai)
#pragma unroll
            for (int m = 0; m < 4; ++m) { const int lrow = ai * HALF + wr * 64 + m * 16 + fr; const bool ok = lrow < u.nvalid; gg[ai][m] = ok ? gate[u.lb + lrow] : 0.f; dd[ai][m] = ok ? ydst[u.lb + lrow] : -1; }
#pragma unroll
        for (int ai = 0; ai < 2; ++ai)
#pragma unroll
            for (int m = 0; m < 4; ++m) { const float gt = gg[ai][m]; if (dd[ai][m] >= 0) {
#pragma unroll
                for (int bj = 0; bj < 2; ++bj) { const f32x4 v0 = acc[ai][bj][m][0] * gt, v1 = acc[ai][bj][m][1] * gt;
                    u32x4 w; w.x = cvt_pk_bf16(v0[0], v0[1]); w.y = cvt_pk_bf16(v0[2], v0[3]); w.z = cvt_pk_bf16(v1[0], v1[1]); w.w = cvt_pk_bf16(v1[2], v1[3]);
                    *(u32x4*)(y + (size_t)dd[ai][m] * DM + col0 + bj * HALF) = w; } } }
    }
};


struct EpiPart {
    static constexpr bool PERM = true, AFTER_DRAIN = false;
    float* part;
    __device__ __forceinline__ void operator()(const f32x4 (&acc)[2][2][4][2], const Unit& u, int wr, int wc, int fr_, int fq) const {
        int fr = fr_; asm volatile("" : "+v"(fr));
        float* base = part + (size_t)u.lb * 65536 + wc * 32 + 8 * fq;
#pragma unroll
        for (int ai = 0; ai < 2; ++ai)
#pragma unroll
            for (int m = 0; m < 4; ++m) { float* rp = base + (size_t)(ai * HALF + wr * 64 + m * 16 + fr) * 256;
#pragma unroll
                for (int bj = 0; bj < 2; ++bj) { *(f32x4*)(rp + bj * HALF) = acc[ai][bj][m][0]; *(f32x4*)(rp + bj * HALF + 4) = acc[ai][bj][m][1]; } }
    }
};

template <class Epi, class Sched, bool ALIGN_EPI = false, bool SP2 = false, bool GA = false>
__device__ __forceinline__ void gemm_phase(PG8_LAS unsigned char* lds, const Gemm g, const Sched& S, const Epi& E, int tid_in) {
    int tid_ = tid_in; asm volatile("" : "+v"(tid_));
    const int tid = tid_, wid = __builtin_amdgcn_readfirstlane(tid >> 6), lane = tid & 63, wr = wid >> 2, wc = wid & 3, fr = lane & 15, fq = lane >> 4;
    const int K = g.K, nt = K / BK, lda = g.lda, ldb = g.ldb;
    unsigned voffA[2], voffB[2];
#pragma unroll
    for (int i = 0; i < 2; ++i) { int R, C; stage_rc(tid * 16 + i * 8192, R, C); const int Rb = Epi::PERM ? ((R & ~31) + perm32(R & 31)) : R;
        voffA[i] = (unsigned)(R * lda + C) * 2u; voffB[i] = (unsigned)(Rb * ldb + C) * 2u; }
    unsigned gA0[2] = {0u, 0u}, gA1[2] = {0u, 0u}; PG8_LAS int* const tokL = (PG8_LAS int*)(lds + TOK_OFF); (void)gA0; (void)gA1; (void)tokL;
    static_assert(SP2 || !GA, "gathered A needs the SP2 loop");
    const size_t kstep = (size_t)(BK * 2);
    const size_t hstepA = (size_t)HALF * lda * 2, hstepB = (size_t)HALF * ldb * 2;
    const unsigned ldsw = (unsigned)wid * 1024u;
    const int aoff = lds_byte(wr * 64 + fr, fq * 8), boff = lds_byte(wc * 32 + fr, fq * 8);
#define PG8_SA(b, h) (((b) * 2 + (h)) * HTB)
#define PG8_SB(b, h) ((4 + (b) * 2 + (h)) * HTB)
#define PG8_STAGE(bufoff, gbase, voff) do { _Pragma("unroll") for (int _i = 0; _i < 2; ++_i) \
        __builtin_amdgcn_global_load_lds((const unsigned*)((const char*)(gbase) + (voff)[_i]), (PG8_LAS unsigned*)(lds + (bufoff) + ldsw + _i * 8192), 16, 0, 0); } while (0)
#define PG8_STAGE_A(bufoff, gbase, h) do { if constexpr (GA) { if ((h) == 0) PG8_STAGE(bufoff, gbase, gA0); else PG8_STAGE(bufoff, gbase, gA1); } \
        else { if ((h) == 0) PG8_STAGE(bufoff, gbase, voffA); else PG8_STAGE(bufoff, (gbase) + hstepA, voffA); } } while (0)
#define PG8_GOFFS(buf, un) do { _Pragma("unroll") for (int _i = 0; _i < 2; ++_i) { int R_, C_; stage_rc(tid * 16 + _i * 8192, R_, C_); \
        int t0_, t1_; asm volatile("ds_read_b32 %0, %2\n\tds_read_b32 %1, %2 offset:512\n\ts_waitcnt lgkmcnt(0)" : "=&v"(t0_), "=&v"(t1_) : "v"((unsigned)(size_t)(tokL + (buf) * 256 + R_)) : "memory");     \
        t0_ = (R_ < (un).nvalid) ? t0_ : 0; t1_ = (128 + R_ < (un).nvalid) ? t1_ : 0; \
        gA0[_i] = (unsigned)(t0_ * lda + C_) * 2u; gA1[_i] = (unsigned)(t1_ * lda + C_) * 2u; } } while (0)
#define PG8_TOKDMA(buf, un) __builtin_amdgcn_global_load_lds((const unsigned*)(S.tok_src(un) + lane * 4), (PG8_LAS unsigned*)(tokL + (buf) * 256), 16, 0, 0)
#define PG8_LDA(dst, b, h) do { _Pragma("unroll") for (int m = 0; m < 4; ++m) _Pragma("unroll") for (int k = 0; k < 2; ++k) dst[m][k] = *(const PG8_LAS bf16x8*)(lds + PG8_SA(b, h) + aoff + m * 2048 + k * 1024); } while (0)
#define PG8_LDB(dst, b, h) do { _Pragma("unroll") for (int n = 0; n < 2; ++n) _Pragma("unroll") for (int k = 0; k < 2; ++k) dst[n][k] = *(const PG8_LAS bf16x8*)(lds + PG8_SB(b, h) + boff + n * 2048 + k * 1024); } while (0)
#define PG8_MMA(ai, bj, At, Bt) do { __builtin_amdgcn_s_setprio(1); _Pragma("unroll") for (int m = 0; m < 4; ++m) _Pragma("unroll") for (int n = 0; n < 2; ++n) _Pragma("unroll") for (int k = 0; k < 2; ++k) \
        acc[ai][bj][m][n] = __builtin_amdgcn_mfma_f32_16x16x32_bf16(Bt[n][k], At[m][k], acc[ai][bj][m][n], 0, 0, 0); __builtin_amdgcn_s_setprio(0); } while (0)
#define PG8_WAIT_V(n) asm volatile("s_waitcnt vmcnt(" #n ")" ::: "memory")
#define PG8_WAIT_L(n) asm volatile("s_waitcnt lgkmcnt(" #n ")" ::: "memory")
#define PG8_BAR __builtin_amdgcn_s_barrier()
#define PG8_SCHED __builtin_amdgcn_sched_barrier(0)
    Unit cur, nxt; int ui = 0;
    if (!S.next(0, cur)) return;
    f32x4 acc[2][2][4][2];
#pragma unroll
    for (int a = 0; a < 2; ++a)
#pragma unroll
        for (int b = 0; b < 2; ++b)
#pragma unroll
            for (int m = 0; m < 4; ++m)
#pragma unroll
                for (int n = 0; n < 2; ++n) acc[a][b][m][n] = (f32x4){0.f, 0.f, 0.f, 0.f};
    bf16x8 At[4][2], B0[2][2], B1[2][2];
    const char* cA = cur.a; const char* cB = cur.b;
    S.a_ready(cur);
    if constexpr (GA) { if (wid == 0) PG8_TOKDMA(0, cur); PG8_WAIT_V(0); PG8_BAR; PG8_GOFFS(0, cur); }
    if constexpr (SP2) {
        PG8_STAGE(PG8_SB(0, 0), cB, voffB); PG8_STAGE(PG8_SB(0, 1), cB + hstepB, voffB); PG8_STAGE_A(PG8_SA(0, 0), cA, 0); PG8_STAGE_A(PG8_SA(0, 1), cA, 1);
        if (wr == 1) PG8_BAR;
        PG8_WAIT_V(2); PG8_BAR;
        PG8_STAGE(PG8_SB(1, 0), cB + kstep, voffB); PG8_STAGE_A(PG8_SA(1, 0), cA + kstep, 0); PG8_STAGE(PG8_SB(1, 1), cB + hstepB + kstep, voffB);
        PG8_WAIT_V(6); PG8_BAR;
    } else {
        PG8_STAGE(PG8_SB(0, 0), cB, voffB); PG8_STAGE(PG8_SA(0, 0), cA, voffA); PG8_STAGE(PG8_SB(0, 1), cB + hstepB, voffB); PG8_STAGE(PG8_SA(0, 1), cA + hstepA, voffA);
        if (wr == 1) PG8_BAR;
        PG8_WAIT_V(4); PG8_BAR;
        PG8_STAGE(PG8_SB(1, 0), cB + kstep, voffB); PG8_STAGE(PG8_SA(1, 0), cA + kstep, voffA); PG8_STAGE(PG8_SB(1, 1), cB + hstepB + kstep, voffB);
        PG8_WAIT_V(6); PG8_BAR;
    }
    for (;;) {
        const bool has_next = S.next(ui + 1, nxt);
        if constexpr (GA) { if (has_next && wid == 0) PG8_TOKDMA((ui + 1) & 1, nxt); }
        const char* nA = has_next ? nxt.a : cA; const char* nB = has_next ? nxt.b : cB;
#pragma nounroll
        for (int t = 0; t < nt; t += 2) {
            const bool last = (t == nt - 2);
            const char* a1 = cA + (size_t)(t + 1) * kstep;
            const char* a2 = last ? nA : cA + (size_t)(t + 2) * kstep; const char* b2 = last ? nB : cB + (size_t)(t + 2) * kstep;
            const char* a3 = a2 + kstep; const char* b3 = b2 + kstep;
            if (last && has_next) S.a_ready(nxt);
            if constexpr (SP2) {
            PG8_LDB(B0, 0, 0); PG8_LDB(B1, 0, 1); PG8_SCHED; PG8_LDA(At, 0, 0); PG8_STAGE_A(PG8_SA(1, 1), a1, 1);
            if constexpr (GA) { if (last && has_next) PG8_GOFFS((ui + 1) & 1, nxt); }
            PG8_WAIT_V(8); PG8_WAIT_L(0); PG8_BAR; PG8_MMA(0, 0, At, B0); PG8_MMA(0, 1, At, B1); PG8_BAR; PG8_SCHED;
            PG8_LDA(At, 0, 1); PG8_STAGE(PG8_SB(0, 0), b2, voffB); PG8_STAGE(PG8_SB(0, 1), b2 + hstepB, voffB); PG8_STAGE_A(PG8_SA(0, 0), a2, 0);
            PG8_WAIT_V(8); PG8_WAIT_L(0); PG8_BAR; PG8_MMA(1, 0, At, B0); PG8_MMA(1, 1, At, B1); PG8_BAR; PG8_SCHED;
            PG8_LDB(B0, 1, 0); PG8_LDB(B1, 1, 1); PG8_SCHED; PG8_LDA(At, 1, 0); PG8_STAGE_A(PG8_SA(0, 1), a2, 1);
            PG8_WAIT_V(8); PG8_WAIT_L(0); PG8_BAR; PG8_MMA(0, 0, At, B0); PG8_MMA(0, 1, At, B1); PG8_BAR; PG8_SCHED;
            PG8_LDA(At, 1, 1); PG8_STAGE(PG8_SB(1, 0), b3, voffB); PG8_STAGE(PG8_SB(1, 1), b3 + hstepB, voffB); PG8_STAGE_A(PG8_SA(1, 0), a3, 0);
            PG8_WAIT_V(8); PG8_WAIT_L(0); PG8_BAR; PG8_MMA(1, 0, At, B0); PG8_MMA(1, 1, At, B1); PG8_BAR; PG8_SCHED;
            } else {
            PG8_LDB(B0, 0, 0); PG8_SCHED; PG8_LDA(At, 0, 0); PG8_STAGE(PG8_SA(1, 1), a1 + hstepA, voffA);
            PG8_WAIT_L(8); PG8_BAR; PG8_WAIT_L(0); PG8_MMA(0, 0, At, B0); PG8_BAR; PG8_SCHED;
            PG8_LDB(B1, 0, 1); PG8_STAGE(PG8_SB(0, 0), b2, voffB);
            PG8_BAR; PG8_WAIT_L(0); PG8_MMA(0, 1, At, B1); PG8_BAR;
            PG8_LDA(At, 0, 1); PG8_STAGE(PG8_SA(0, 0), a2, voffA);
            PG8_BAR; PG8_WAIT_L(0); PG8_MMA(1, 0, At, B0); PG8_BAR; PG8_SCHED;
            PG8_STAGE(PG8_SB(0, 1), b2 + hstepB, voffB);
            PG8_WAIT_V(6); PG8_BAR; PG8_MMA(1, 1, At, B1); PG8_BAR;
            PG8_LDB(B0, 1, 0); PG8_SCHED; PG8_LDA(At, 1, 0); PG8_STAGE(PG8_SA(0, 1), a2 + hstepA, voffA);
            PG8_WAIT_L(8); PG8_BAR; PG8_WAIT_L(0); PG8_MMA(0, 0, At, B0); PG8_BAR; PG8_SCHED;
            PG8_LDB(B1, 1, 1); PG8_STAGE(PG8_SB(1, 0), b3, voffB);
            PG8_BAR; PG8_WAIT_L(0); PG8_MMA(0, 1, At, B1); PG8_BAR;
            PG8_LDA(At, 1, 1); PG8_STAGE(PG8_SA(1, 0), a3, voffA);
            PG8_BAR; PG8_WAIT_L(0); PG8_MMA(1, 0, At, B0); PG8_BAR; PG8_SCHED;
            PG8_STAGE(PG8_SB(1, 1), b3 + hstepB, voffB);
            PG8_WAIT_V(6); PG8_BAR; PG8_MMA(1, 1, At, B1); PG8_BAR;
            }
        }
        if constexpr (ALIGN_EPI) { if (wr == 0) PG8_BAR; }
        if constexpr (!Epi::AFTER_DRAIN) { E(acc, cur, wr, wc, fr, fq); S.done(cur); }
        if (!has_next) break;
#pragma unroll
        for (int a = 0; a < 2; ++a)
#pragma unroll
            for (int b = 0; b < 2; ++b)
#pragma unroll
                for (int m = 0; m < 4; ++m)
#pragma unroll
                    for (int n = 0; n < 2; ++n) acc[a][b][m][n] = (f32x4){0.f, 0.f, 0.f, 0.f};
        cur = nxt; cA = nA; cB = nB; ++ui;
        if constexpr (ALIGN_EPI) { if (wr == 1) PG8_BAR; }
    }
    PG8_WAIT_V(0);
    if constexpr (!ALIGN_EPI) { if (wr == 0) PG8_BAR; }
    PG8_BAR;
    if constexpr (Epi::AFTER_DRAIN) { E.fused(acc, cur, wr, wc, fr, fq, lds, wid, lane); S.done(cur); }
#undef PG8_SA
#undef PG8_SB
#undef PG8_STAGE
#undef PG8_STAGE_A
#undef PG8_GOFFS
#undef PG8_TOKDMA
#undef PG8_LDA
#undef PG8_LDB
#undef PG8_MMA
#undef PG8_WAIT_V
#undef PG8_WAIT_L
#undef PG8_BAR
#undef PG8_SCHED
}
}

namespace att {
__device__ __forceinline__ int koff(int row, int ch) { return row * 128 + ((ch ^ (((row >> 1) & 3) << 1)) << 4); }
constexpr int LDS_K = 0, LDS_V = 32768, OST_OFF = RING_BYTES + 1024;
__device__ __forceinline__ s16x4 vtr(const LAS unsigned char* p) { return __builtin_bit_cast(s16x4, __builtin_amdgcn_ds_read_tr16_b64_v4i16((LAS s16x4*)p)); }

constexpr int NU = 5120;
__device__ __forceinline__ void decode_unit(int u, int& g, int& seq, int& jt) {
    g = u >> 11; const int ug = u & 2047;
    if (g == 0) { seq = ug >> 4; jt = (ug + seq) & 15; } else if (g == 1) { seq = ug >> 2; jt = (ug + seq) & 3; } else { seq = 2 * ug; jt = 0; }
}
__device__ __forceinline__ void load_tile(u32x4 (&pf)[8], const bf16_t* qkvb, int u, int tid) {
    int g, seq, jt; decode_unit(u, g, seq, jt); const int Lg = SEQ >> (2 * g);
    const bf16_t* kb = qkvb + (size_t)(g * 3 + 1) * ((size_t)HTOK * DM) + ((size_t)seq * Lg + (size_t)jt * 128 - 128) * HDIM;
    const bf16_t* vb = kb + (size_t)HTOK * DM;
    const size_t pair = (g == 2) ? (size_t)(Lg + 128) * HDIM : 0;
#pragma unroll
    for (int i = 0; i < 4; ++i) { const int q = tid + 512 * i; const bool lo = q < 1024, ok = (jt > 0) || !lo || (g == 2); const size_t o = (size_t)q * 8 + ((lo && g == 2) ? pair : 0);
        pf[i] = ok ? *(const u32x4*)(kb + o) : (u32x4){0u, 0u, 0u, 0u}; pf[4 + i] = ok ? *(const u32x4*)(vb + o) : (u32x4){0u, 0u, 0u, 0u}; }
}
__device__ __forceinline__ void load_q(bf16x8& q0, bf16x8& q1, bf16x8& q2, bf16x8& q3, const bf16_t* qkvb, int u, int wid, int lane) {
    int g, seq, jt; decode_unit(u, g, seq, jt); const int Lg = SEQ >> (2 * g); const bf16_t* qbase = qkvb + (size_t)(g * 3) * ((size_t)HTOK * DM) + 8 * (lane >> 4);
    const bool pr = (g == 2), lo = wid < 4;
    const int sF = pr ? (lo ? seq : seq + 1) : seq, rF = pr ? (lo ? wid + 4 : wid) * 16 : jt * 128 + wid * 16, sH = pr ? (lo ? seq + 1 : seq) : sF, rH = pr ? (wid & 3) * 16 : rF;
    const bf16_t* qf = qbase + ((size_t)sF * Lg + rF + (lane & 15)) * HDIM; const bf16_t* qh = qbase + ((size_t)sH * Lg + rH + (lane & 15)) * HDIM;
    q0 = *(const bf16x8*)qf; q1 = *(const bf16x8*)(qf + 32); q2 = *(const bf16x8*)qh; q3 = *(const bf16x8*)(qh + 32);
}
__device__ __forceinline__ void store_tile(const u32x4 (&pf)[8], LAS unsigned char* lds, int tid) {
#pragma unroll
    for (int i = 0; i < 4; ++i) { const int q = tid + 512 * i, row = q >> 3, ch = q & 7; *(LAS u32x4*)(lds + LDS_K + koff(row, ch)) = pf[i]; *(LAS u32x4*)(lds + LDS_V + koff(row, ch)) = pf[4 + i]; }
}
__device__ __forceinline__ float max3(float a, float b, float c) { return __builtin_fmaxf(__builtin_fmaxf(a, b), c); }
__device__ __forceinline__ float xrow_max(float v) {
    auto r = __builtin_amdgcn_permlane16_swap(__float_as_uint(v), __float_as_uint(v), false, false); v = __builtin_fmaxf(__uint_as_float(r[0]), __uint_as_float(r[1]));
    auto q = __builtin_amdgcn_permlane32_swap(__float_as_uint(v), __float_as_uint(v), false, false); return __builtin_fmaxf(__uint_as_float(q[0]), __uint_as_float(q[1])); }
__device__ __forceinline__ float xrow_sum(float v) {
    auto r = __builtin_amdgcn_permlane16_swap(__float_as_uint(v), __float_as_uint(v), false, false); v = __uint_as_float(r[0]) + __uint_as_float(r[1]);
    auto q = __builtin_amdgcn_permlane32_swap(__float_as_uint(v), __float_as_uint(v), false, false); return __uint_as_float(q[0]) + __uint_as_float(q[1]); }
template <int TS>
__device__ __forceinline__ void compute_unit(const LAS unsigned char* ldsb, LAS unsigned char* ost, const bf16x8 q0, const bf16x8 q1, bf16_t* opart, float* lse, int g, int seq, int jt, int wid, int rshift, int lane) {
    const int dsh = 2 * g, Lg = SEQ >> dsh; const LAS unsigned char* lds = ldsb + rshift;
    const int fr = lane & 15, grp = lane >> 4;
    const int h = seq & 15, br = seq >> 4, bl = br >> dsh, r = br & ((1 << dsh) - 1);
    const int j = jt * 128 + wid * 16 + fr;
    (void)Lg;
    const int t0 = (jt == 0) ? (8 - wid) : 0;
    const int s2 = ((fr >> 1) & 3) << 1;
    const LAS unsigned char* kb0 = lds + LDS_K + (wid * 16 + fr) * 128 + ((grp ^ s2) << 4);
    const LAS unsigned char* kb1 = lds + LDS_K + (wid * 16 + fr) * 128 + (((4 + grp) ^ s2) << 4);
    f32x4 S[9];
#pragma unroll
    for (int t = 0; t < TS; ++t) S[t] = (f32x4){-1e30f, -1e30f, -1e30f, -1e30f};
    constexpr int TM = (TS == 0) ? 5 : 9;
    {   bf16x8 kf0[9], kf1[9];
#pragma unroll
        for (int t = TS; t < TM; ++t) { kf0[t] = *(const LAS bf16x8*)(kb0 + t * 2048); kf1[t] = *(const LAS bf16x8*)(kb1 + t * 2048); }
        __builtin_amdgcn_sched_barrier(0);
#pragma unroll
        for (int t = TS; t < TM; ++t) S[t] = __builtin_amdgcn_mfma_f32_16x16x32_bf16(kf0[t], q0, (f32x4){0.f, 0.f, 0.f, 0.f}, 0, 0, 0);
#pragma unroll
        for (int t = TS; t < TM; ++t) S[t] = __builtin_amdgcn_mfma_f32_16x16x32_bf16(kf1[t], q1, S[t], 0, 0, 0);
        __builtin_amdgcn_sched_barrier(0);
#pragma unroll
        for (int t = TM; t < 9; ++t) { kf0[t] = *(const LAS bf16x8*)(kb0 + t * 2048); kf1[t] = *(const LAS bf16x8*)(kb1 + t * 2048); }
        __builtin_amdgcn_sched_barrier(0);
#pragma unroll
        for (int t = TM; t < 9; ++t) S[t] = __builtin_amdgcn_mfma_f32_16x16x32_bf16(kf0[t], q0, (f32x4){0.f, 0.f, 0.f, 0.f}, 0, 0, 0);
#pragma unroll
        for (int t = TM; t < 9; ++t) S[t] = __builtin_amdgcn_mfma_f32_16x16x32_bf16(kf1[t], q1, S[t], 0, 0, 0);
    }
    __builtin_amdgcn_sched_barrier(0);
    const int iq = fr >> 2, ip = fr & 3, sv2 = ((iq >> 1) | ((grp & 1) << 1)) << 1;
    const LAS unsigned char* vrow = lds + LDS_V + (wid * 16 + 4 * grp + iq) * 128 + 8 * (ip & 1);
    s16x4 vl[5][4], vh[4][4];
#pragma unroll
    for (int dt = 0; dt < 4; ++dt) { const LAS unsigned char* vb = vrow + (((2 * dt + (ip >> 1)) ^ sv2) << 4);
#pragma unroll
        for (int c = TS / 2; c < 3; ++c) { vl[c][dt] = vtr(vb + c * 4096); vh[c][dt] = vtr(vb + c * 4096 + 2048); } }
    __builtin_amdgcn_sched_barrier(0);
    const float NEG = -1e30f;
    if (t0 > 0) {
#pragma unroll
        for (int t = TS; t < 8; ++t) { const bool tv = t >= t0; S[t][0] = tv ? S[t][0] : NEG; S[t][1] = tv ? S[t][1] : NEG; S[t][2] = tv ? S[t][2] : NEG; S[t][3] = tv ? S[t][3] : NEG; } }
#pragma unroll
    for (int e = 0; e < 4; ++e) { if (TS == 0) S[0][e] = (4 * grp + e >= fr) ? S[0][e] : NEG; S[8][e] = (4 * grp + e <= fr) ? S[8][e] : NEG; }
    float mx = max3(S[0][0], S[0][1], S[0][2]);
    mx = max3(mx, S[0][3], S[8][3]);
#pragma unroll
    for (int t = 1; t < 8; ++t) { mx = max3(mx, S[t][0], S[t][1]); mx = max3(mx, S[t][2], S[t][3]); }
    mx = max3(mx, S[8][0], S[8][1]); mx = __builtin_fmaxf(mx, S[8][2]);
    mx = xrow_max(mx);
    f32x4 lsv = {0.f, 0.f, 0.f, 0.f};
#pragma unroll
    for (int t = TS; t < 9; ++t) { const f32x4 d = S[t] - mx;
        S[t][0] = __builtin_amdgcn_exp2f(d[0]); S[t][1] = __builtin_amdgcn_exp2f(d[1]); S[t][2] = __builtin_amdgcn_exp2f(d[2]); S[t][3] = __builtin_amdgcn_exp2f(d[3]);
        lsv = lsv + S[t]; }
    float ls = (lsv[0] + lsv[1]) + (lsv[2] + lsv[3]);
    ls = xrow_sum(ls);
    bf16x8 pf[5];
#pragma unroll
    for (int c = TS / 2; c < 5; ++c) { u32x4 pw; pw.x = cvt_pk_bf16(S[2 * c][0], S[2 * c][1]); pw.y = cvt_pk_bf16(S[2 * c][2], S[2 * c][3]);
        if (c < 4) { pw.z = cvt_pk_bf16(S[2 * c + 1][0], S[2 * c + 1][1]); pw.w = cvt_pk_bf16(S[2 * c + 1][2], S[2 * c + 1][3]); } else { pw.z = 0u; pw.w = 0u; }
        pf[c] = __builtin_bit_cast(bf16x8, pw); }
    __builtin_amdgcn_sched_barrier(0);
#pragma unroll
    for (int dt = 0; dt < 4; ++dt) { const LAS unsigned char* vb = vrow + (((2 * dt + (ip >> 1)) ^ sv2) << 4);
        vl[3][dt] = vtr(vb + 3 * 4096); vh[3][dt] = vtr(vb + 3 * 4096 + 2048); vl[4][dt] = vtr(vb + 4 * 4096); }
    __builtin_amdgcn_sched_barrier(0);
    f32x4 O[4];
#pragma unroll
    for (int dt = 0; dt < 4; ++dt) O[dt] = (f32x4){0.f, 0.f, 0.f, 0.f};
#pragma unroll
    for (int c = TS / 2; c < 5; ++c)
#pragma unroll
        for (int dt = 0; dt < 4; ++dt) { const s16x4 lo = vl[c][dt]; s16x4 hi = (s16x4){0, 0, 0, 0}; if (c < 4) hi = vh[c][dt];
            const bf16x8 vf = (bf16x8){lo[0], lo[1], lo[2], lo[3], hi[0], hi[1], hi[2], hi[3]};
            O[dt] = __builtin_amdgcn_mfma_f32_16x16x32_bf16(vf, pf[c], O[dt], 0, 0, 0); }
    __builtin_amdgcn_sched_barrier(0);
    const float inv = __builtin_amdgcn_rcpf(ls);
    const size_t tokrow = (size_t)bl * SEQ + ((size_t)j << dsh) + r;
#pragma unroll
    for (int dt = 0; dt < 4; ++dt) { u32x2 w; w.x = cvt_pk_bf16(O[dt][0] * inv, O[dt][1] * inv); w.y = cvt_pk_bf16(O[dt][2] * inv, O[dt][3] * inv); *(LAS u32x2*)(ost + fr * 128 + dt * 32 + grp * 8) = w; }
    LDS_WAIT();
#pragma unroll
    for (int k = 0; k < 2; ++k) { const int qq = (lane >> 3) + 8 * k; const u32x4 w = *(const LAS u32x4*)(ost + qq * 128 + (lane & 7) * 16);
        const size_t trow = (size_t)bl * SEQ + ((size_t)(jt * 128 + wid * 16 + qq) << dsh) + r;
        *(u32x4*)(opart + (size_t)g * ((size_t)HTOK * DM) + trow * DM + h * HDIM + (lane & 7) * 8) = w; }
    if (grp == 0) lse[(size_t)g * ((size_t)HTOK * NHEAD) + tokrow * NHEAD + h] = mx + __builtin_amdgcn_logf(ls);
}
__device__ __forceinline__ void attn_phase(LAS unsigned char* lds, const bf16_t* qkvb, bf16_t* opart, float* lse, int G, int c, int tid_in) {
    int tid_ = tid_in; asm volatile("" : "+v"(tid_));
    const int tid = tid_, wid = __builtin_amdgcn_readfirstlane(tid >> 6), lane = tid & 63;
    u32x4 pA[8]; bf16x8 q0, q1, q2, q3, a0, a1, a2, a3;
    LAS unsigned char* ost = lds + OST_OFF + wid * 2048;
    int u = c, buf = 0;
    if (u < NU) { load_tile(pA, qkvb, u, tid); load_q(q0, q1, q2, q3, qkvb, u, wid, lane); store_tile(pA, lds, tid); }
    __syncthreads();
    while (u < NU) {
        const bool more = u + G < NU;
        if (more) { load_tile(pA, qkvb, u + G, tid); load_q(a0, a1, a2, a3, qkvb, u + G, wid, lane); }
        { int g_, s_, jt_; decode_unit(u, g_, s_, jt_); const LAS unsigned char* lb_ = lds + buf * 65536;
          if (g_ < 2) compute_unit<0>(lb_, ost, q0, q1, opart, lse, g_, s_, jt_, wid, 0, lane);
          else { const bool lo_ = wid < 4;
              compute_unit<0>(lb_, ost, q0, q1, opart, lse, 2, lo_ ? s_ : s_ + 1, 0, lo_ ? wid + 4 : wid, lo_ ? 0 : -16384, lane);
              compute_unit<4>(lb_, ost, q2, q3, opart, lse, 2, lo_ ? s_ + 1 : s_, 0, wid & 3, lo_ ? -16384 : 0, lane); } }
        if (more) { store_tile(pA, lds + (buf ^ 1) * 65536, tid); q0 = a0; q1 = a1; q2 = a2; q3 = a3; }
        asm volatile("s_waitcnt lgkmcnt(0)" ::: "memory"); __builtin_amdgcn_s_barrier(); asm volatile("" ::: "memory");
        buf ^= 1; u += G;
    }
}
}
struct Args { const float* in[15]; float* out; unsigned char* ws; int ph_lo, ph_hi, li, pad; };
struct Frame {
    LAS unsigned char* lds; unsigned* ctl; int tid, lane, wave, vcu, G;
    const float *x_in, *mix_norm, *ffn_norm, *w_qkv, *w_o, *pool_w, *pool_scale, *dg, *du, *dd, *router, *mg, *mu, *md, *final_norm;
    float* xo; unsigned char* ws;
};
typedef const __attribute__((address_space(4))) Args* KArgs;
__device__ __forceinline__ void build_frame(Frame& F, LAS unsigned char* lds, int wv) {
    KArgs A = (KArgs)__builtin_amdgcn_kernarg_segment_ptr(); asm volatile("" : "+s"(A));
    F.lds = lds; F.lane = lane_id(); F.wave = wv; F.tid = wv * 64 + F.lane;
    F.G = gridDim.x; { const int bx = blockIdx.x; F.vcu = (F.G % 8 == 0) ? (bx % 8) * (F.G / 8) + bx / 8 : bx; }
    F.ws = A->ws; F.ctl = (unsigned*)(A->ws + WS_CTL); F.xo = A->out;
    F.x_in = A->in[0]; F.mix_norm = A->in[1]; F.ffn_norm = A->in[2]; F.w_qkv = A->in[3]; F.w_o = A->in[4]; F.pool_w = A->in[5]; F.pool_scale = A->in[6];
    F.dg = A->in[7]; F.du = A->in[8]; F.dd = A->in[9]; F.router = A->in[10]; F.mg = A->in[11]; F.mu = A->in[12]; F.md = A->in[13]; F.final_norm = A->in[14];
}
struct ConvItem { const float* W; bf16_t* WT; const float* gain; int K, N, mode, item; };
__device__ __forceinline__ void conv_load(f32x4 (&v)[8], const ConvItem& c, int lane) {
    const int nblk = c.N / 32, kb = c.item / nblk, nb = c.item - kb * nblk;
    const float* p = c.W + (size_t)(64 * kb + (lane >> 3)) * c.N + 32 * nb + 4 * (lane & 7);
#pragma unroll
    for (int i = 0; i < 8; ++i) v[i] = *(const f32x4*)(p + (size_t)(8 * i) * c.N);
}
__device__ __forceinline__ void conv_store(const f32x4 (&v)[8], const ConvItem& c, LAS float* scr, int lane) {
    const int nblk = c.N / 32, kb = c.item / nblk, nb = c.item - kb * nblk, k0 = 64 * kb, n0 = 32 * nb;
    int rbase = n0, rstride = 1;
    if (c.mode == 1) rbase = (n0 >> 7) * 256 + (n0 & 127);
    else if (c.mode == 2) rbase = (n0 >> 7) * 256 + 128 + (n0 & 127);
    else if (c.mode == 3) { const int t = (n0 % 3072) >> 10; if (t < 2) { rbase = (n0 & ~63) + ((n0 >> 5) & 1); rstride = 2; } }
#pragma unroll
    for (int i = 0; i < 8; ++i)
#pragma unroll
        for (int q = 0; q < 4; ++q) scr[(4 * (lane & 7) + q) * 65 + 8 * i + (lane >> 3)] = v[i][q];
    LDS_WAIT(); asm volatile("" ::: "memory");
    const int cc = lane & 7;
    f32x4 g0 = {1.f, 1.f, 1.f, 1.f}, g1 = g0; if (c.gain) { g0 = *(const f32x4*)(c.gain + k0 + 8 * cc); g1 = *(const f32x4*)(c.gain + k0 + 8 * cc + 4); }
#pragma unroll
    for (int j = 0; j < 4; ++j) { const int n = (lane >> 3) + 8 * j; const LAS float* s = scr + n * 65 + 8 * cc;
        u32x4 o; o.x = pk2(s[0] * g0[0], s[1] * g0[1]); o.y = pk2(s[2] * g0[2], s[3] * g0[3]); o.z = pk2(s[4] * g1[0], s[5] * g1[1]); o.w = pk2(s[6] * g1[2], s[7] * g1[3]);
        *(u32x4*)(c.WT + (size_t)(rbase + rstride * n) * c.K + k0 + 8 * cc) = o; }
    LDS_WAIT(); asm volatile("" ::: "memory");
}
template <class Resolve> __device__ __forceinline__ void convert_run(Frame& F, int first, int total, int pidx, int P, const Resolve& R) {
    LAS float* scr = (LAS float*)(F.lds + F.wave * 16384);
    const int NGW = P * 8; int it = first + pidx * 8 + F.wave;
    f32x4 v[8], vn[8], vm[8]; ConvItem cur, nx, nn;
    if (it < total) { R(it, cur); conv_load(v, cur, F.lane); }
    if (it + NGW < total) { R(it + NGW, nx); conv_load(vn, nx, F.lane); }
    while (it < total) {
        const int n2 = it + 2 * NGW;
        if (n2 < total) { R(n2, nn); conv_load(vm, nn, F.lane); }
        conv_store(v, cur, scr, F.lane);
#pragma unroll
        for (int i = 0; i < 8; ++i) { v[i] = vn[i]; vn[i] = vm[i]; }
        cur = nx; nx = nn;
        it += NGW;
    }
}
__device__ __forceinline__ void convert_moe(Frame& F, int f, int part = 0, int pidx = -1, int P = 0) {
    const size_t EW = (size_t)DM * DFFE;
    constexpr int per = (DM / 64) * (DFFE / 32);
    const float* mg = F.mg; const float* mu = F.mu; const float* md = F.md; unsigned char* ws = F.ws; const float* gn = F.ffn_norm + (size_t)(2 * f + 1) * DM;
    if (pidx < 0) { pidx = F.vcu; P = F.G; }
    convert_run(F, part == 2 ? 2 * 8 * per : 0, part == 1 ? 2 * 8 * per : 3 * 8 * per, pidx, P, [=](int it, ConvItem& c) { const int which = it / (8 * per), rr = it - which * 8 * per, e = rr / per; c.item = rr - e * per;
        if (which == 0)      { c.W = mg + ((size_t)f * 8 + e) * EW; c.K = DM; c.N = DFFE; c.WT = (bf16_t*)(ws + WS_WMGU) + (size_t)e * 2 * EW; c.mode = 1; c.gain = gn; }
        else if (which == 1) { c.W = mu + ((size_t)f * 8 + e) * EW; c.K = DM; c.N = DFFE; c.WT = (bf16_t*)(ws + WS_WMGU) + (size_t)e * 2 * EW; c.mode = 2; c.gain = gn; }
        else                 { c.W = md + ((size_t)f * 8 + e) * EW; c.K = DFFE; c.N = DM; c.WT = (bf16_t*)(ws + WS_WMD) + (size_t)e * EW; c.mode = 0; c.gain = nullptr; } });
}
__device__ __forceinline__ void convert_static(Frame& F) {
    constexpr int P_QKV = (DM / 64) * (NQKV / 32), P_O = (DM / 64) * (DM / 32), P_POOL = 4 * 8, P_DG = (DM / 64) * (DFF / 32), P_DD = (DFF / 64) * (DM / 32);
    constexpr int T0 = 2 * P_QKV, T1 = T0 + 2 * P_O, T2 = T1 + 8 * P_POOL, T3 = T2 + 2 * P_DG, T4 = T3 + 2 * P_DG, T5 = T4 + 2 * P_DD;
    const float* w_qkv = F.w_qkv; const float* w_o = F.w_o; const float* pool_w = F.pool_w; const float* dg = F.dg; const float* du = F.du; const float* dd = F.dd; unsigned char* ws = F.ws; const float* mixn = F.mix_norm; const float* ffnn = F.ffn_norm;
    convert_run(F, 0, T5, F.vcu, F.G, [=](int it, ConvItem& c) {
        if (it < T0) { const int l = it / P_QKV; c.item = it - l * P_QKV; c.W = w_qkv + (size_t)l * DM * NQKV; c.K = DM; c.N = NQKV; c.WT = (bf16_t*)(ws + WS_WQKV) + (size_t)l * NQKV * DM; c.mode = 3; c.gain = mixn + (size_t)(2 * l) * DM; }
        else if (it < T1) { const int q = it - T0, l = q / P_O; c.item = q - l * P_O; c.W = w_o + (size_t)l * DM * DM; c.K = DM; c.N = DM; c.WT = (bf16_t*)(ws + WS_WO) + (size_t)l * DM * DM; c.mode = 0; c.gain = nullptr; }
        else if (it < T2) { const int q = it - T1, l = q / P_POOL; c.item = q - l * P_POOL; c.W = pool_w + (size_t)l * 65536; c.K = 256; c.N = 256; c.WT = (bf16_t*)(ws + WS_WPOOL) + (size_t)l * 65536; c.mode = 0; c.gain = nullptr; }
        else if (it < T3) { const int q = it - T2, l = q / P_DG; c.item = q - l * P_DG; c.W = dg + (size_t)l * DM * DFF; c.K = DM; c.N = DFF; c.WT = (bf16_t*)(ws + WS_WDGU) + (size_t)l * 2 * DFF * DM; c.mode = 1; c.gain = ffnn + (size_t)(2 * l) * DM; }
        else if (it < T4) { const int q = it - T3, l = q / P_DG; c.item = q - l * P_DG; c.W = du + (size_t)l * DM * DFF; c.K = DM; c.N = DFF; c.WT = (bf16_t*)(ws + WS_WDGU) + (size_t)l * 2 * DFF * DM; c.mode = 2; c.gain = ffnn + (size_t)(2 * l) * DM; }
        else { const int q = it - T4, l = q / P_DD; c.item = q - l * P_DD; c.W = dd + (size_t)l * DFF * DM; c.K = DFF; c.N = DM; c.WT = (bf16_t*)(ws + WS_WDD) + (size_t)l * DM * DFF; c.mode = 0; c.gain = nullptr; } });
}
__device__ __forceinline__ void rope_table(Frame& F) {
    float* tab = (float*)(F.ws + WS_ROPE);
    for (int i = F.vcu * 512 + F.tid; i < SEQ * 32; i += F.G * 512) { const int s = i >> 5, k = i & 31;
        const float inv = powf(10000.0f, -(float)(2 * k) / 64.0f), ang = (float)s * inv; tab[2 * i] = cosf(ang); tab[2 * i + 1] = sinf(ang); }
    if (F.vcu == 0 && F.tid < 64) { const int k = F.tid & 31; const float inv = powf(10000.0f, -(float)(2 * k) / 64.0f), ang = (F.tid < 32 ? 16.0f : 128.0f) * inv; tab[SEQ * 64 + 2 * F.tid] = cosf(ang); tab[SEQ * 64 + 2 * F.tid + 1] = sinf(ang); }
}
__device__ __forceinline__ float ss16(const float* ssp, size_t row) { float s = 0.f;
#pragma unroll
    for (int q = 0; q < 16; ++q) s += ssp[(size_t)q * NTOK + row];
    return s; }
__device__ __forceinline__ void rinv_pass(Frame& F) { const float* ssp = (const float*)(F.ws + WS_SSP); float* ri = (float*)(F.ws + WS_RINV);
    for (int i = F.vcu * 512 + F.tid; i < NTOK; i += F.G * 512) ri[i] = 1.0f / sqrtf(ss16(ssp, i) * (1.0f / DM) + RMS_EPS); }
__device__ __forceinline__ f32x4 bf4(u32x2 a) { return (f32x4){__builtin_bit_cast(float, a.x << 16), __builtin_bit_cast(float, a.x & 0xffff0000u), __builtin_bit_cast(float, a.y << 16), __builtin_bit_cast(float, a.y & 0xffff0000u)}; }
__device__ __forceinline__ void cast_rows(Frame& F) {
    const int gw = F.vcu * 8 + F.wave, NGW = F.G * 8, lane = F.lane; bf16_t* xb = (bf16_t*)(F.ws + WS_XB); float* rq = (float*)(F.ws + WS_RINV) + NTOK;
    for (int m0 = gw; m0 < NTOK; m0 += 2 * NGW) { const int m1 = (m0 + NGW < NTOK) ? m0 + NGW : m0;
        f32x4 va[4], vb[4];
#pragma unroll
        for (int j = 0; j < 4; ++j) { va[j] = ((const f32x4*)(F.x_in + (size_t)m0 * DM))[lane + 64 * j]; vb[j] = ((const f32x4*)(F.x_in + (size_t)m1 * DM))[lane + 64 * j]; }
#pragma unroll
        for (int q = 0; q < 2; ++q) { const int m = q ? m1 : m0; u32x2* o8 = (u32x2*)(xb + (size_t)m * DM) + lane; float s = 0.f;
#pragma unroll
            for (int j = 0; j < 4; ++j) { const f32x4 v = q ? vb[j] : va[j]; s += (v[0] * v[0] + v[1] * v[1]) + (v[2] * v[2] + v[3] * v[3]); u32x2 w; w.x = pk2(v[0], v[1]); w.y = pk2(v[2], v[3]); o8[64 * j] = w; }
            s = wave_sum(s); if (lane == 0) rq[m] = 1.0f / sqrtf(s * (1.0f / DM) + RMS_EPS); }
    }
}
__device__ __forceinline__ void merge_half(Frame& F, int hb) {
    const bf16_t* op = (const bf16_t*)(F.ws + WS_OPART); const float* lse = (const float*)(F.ws + WS_LSE); bf16_t* out = (bf16_t*)(F.ws + WS_HB) + (size_t)hb * HTOK * DM;
    const int stride = F.G * 512;
    for (int it0 = F.vcu * 512 + F.tid; it0 < HTOK * 128; it0 += 2 * stride) {
        u32x4 a[2], b[2], c[2]; float l0[2], l1[2], l2[2]; size_t off[2];
#pragma unroll
        for (int q = 0; q < 2; ++q) { const int it = (it0 + q * stride < HTOK * 128) ? it0 + q * stride : it0; const int row = it >> 7, ci = it & 127, h = ci >> 3; off[q] = (size_t)row * DM + ci * 8;
            l0[q] = lse[(size_t)row * 16 + h]; l1[q] = lse[(size_t)HTOK * 16 + (size_t)row * 16 + h]; l2[q] = lse[(size_t)2 * HTOK * 16 + (size_t)row * 16 + h];
            a[q] = *(const u32x4*)(op + off[q]); b[q] = *(const u32x4*)(op + (size_t)HTOK * DM + off[q]); c[q] = *(const u32x4*)(op + (size_t)2 * HTOK * DM + off[q]); }
#pragma unroll
        for (int q = 0; q < 2; ++q) {
            const float mx = fmaxf(l0[q], fmaxf(l1[q], l2[q])); float w0 = __builtin_amdgcn_exp2f(l0[q] - mx), w1 = __builtin_amdgcn_exp2f(l1[q] - mx), w2 = __builtin_amdgcn_exp2f(l2[q] - mx);
            const float inv = 1.0f / (w0 + w1 + w2); w0 *= inv; w1 *= inv; w2 *= inv;
            u32x4 o;
#pragma unroll
            for (int k = 0; k < 4; ++k) { const float lo = w0 * bf2f((unsigned short)(a[q][k] & 0xffffu)) + w1 * bf2f((unsigned short)(b[q][k] & 0xffffu)) + w2 * bf2f((unsigned short)(c[q][k] & 0xffffu));
                const float hi = w0 * bf2f((unsigned short)(a[q][k] >> 16)) + w1 * bf2f((unsigned short)(b[q][k] >> 16)) + w2 * bf2f((unsigned short)(c[q][k] >> 16)); o[k] = pk2(lo, hi); }
            *(u32x4*)(out + off[q]) = o; }
    }
}
__device__ __forceinline__ void pool_prep(Frame& F, const float* gain) {
    const bf16_t* x = (const bf16_t*)(F.ws + WS_XB); const float* ssp = (const float*)(F.ws + WS_SSP2); bf16_t* pa = (bf16_t*)(F.ws + WS_HB);
    const int gw = F.vcu * 8 + F.wave, NGW = F.G * 8, lane = F.lane;
    for (int item = gw; item < 16 * 32 * 4; item += NGW) {
        const int b = item >> 7, rem = item & 127, ch = rem >> 2, g = rem & 3, P = 2 << g, t0 = ch * 64, c = 256 * g + 4 * lane;
        const size_t row0 = (size_t)b * SEQ;
        float rA = 0.f, rB = 0.f;
        { const int t = t0 - 16 + lane; if (t >= 0) rA = 1.0f / sqrtf(ss16(ssp, row0 + t) * (1.0f / DM) + RMS_EPS);
          if (lane < 16) rB = 1.0f / sqrtf(ss16(ssp, row0 + t0 + 48 + lane) * (1.0f / DM) + RMS_EPS); }
#define POOL_R(t) (((t) - (t0 - 16)) < 64 ? __builtin_bit_cast(float, __builtin_amdgcn_readlane(__builtin_bit_cast(int, rA), (t) - (t0 - 16))) : __builtin_bit_cast(float, __builtin_amdgcn_readlane(__builtin_bit_cast(int, rB), (t) - (t0 + 48))))
#define POOL_X(t) bf4(*(const u32x2*)(x + (row0 + (t)) * DM + c))
        const f32x4 gm = *(const f32x4*)(gain + c);
        f32x4 S = (f32x4){0.f, 0.f, 0.f, 0.f};
        {   u32x2 xw[16];
#pragma unroll
            for (int i = 0; i < 16; ++i) { const int t = t0 - 16 + i; xw[i] = *(const u32x2*)(x + (row0 + (t > 0 ? t : 0)) * DM + c); }
#pragma unroll
            for (int i = 0; i < 16; ++i) { const int t = t0 - 16 + i; if (t >= t0 - P && t >= 0) { const float r = POOL_R(t); S = S + bf4(xw[i]) * r * gm; } } }
        u32x2 xc[8], xo[8], yc[8], yo[8];
#define POOL_LD(XC, XO, TB) do { _Pragma("unroll") for (int i = 0; i < 8; ++i) { XC[i] = *(const u32x2*)(x + (row0 + (TB) + i) * DM + c); const int tp = (TB) + i - P; XO[i] = *(const u32x2*)(x + (row0 + (tp >= 0 ? tp : 0)) * DM + c); } } while (0)
#define POOL_DO(XC, XO, TB) do { _Pragma("unroll") for (int i = 0; i < 8; ++i) { const int t = (TB) + i; \
                const float r = POOL_R(t); const f32x4 cur = bf4(XC[i]) * r * gm; S = S + cur; \
                if (t - P >= 0) { const float r2 = POOL_R(t - P); S = S - bf4(XO[i]) * r2 * gm; } \
                const float ic = 1.0f / (float)(t + 1 < P ? t + 1 : P); const f32x4 o = S * ic - cur; \
                u32x2 w; w.x = pk2(o[0], o[1]); w.y = pk2(o[2], o[3]); *(u32x2*)(pa + (row0 + t) * DM + c) = w; } } while (0)
        POOL_LD(xc, xo, t0);
        for (int tb = t0; tb < t0 + 64; tb += 16) {
            POOL_LD(yc, yo, tb + 8); POOL_DO(xc, xo, tb);
            if (tb + 16 < t0 + 64) POOL_LD(xc, xo, tb + 16);
            POOL_DO(yc, yo, tb + 8);
        }
#undef POOL_LD
#undef POOL_DO
#undef POOL_R
#undef POOL_X
    }
}
__device__ __forceinline__ void router_pass(Frame& F, int lp, const float* gain, const float* wr) {
    const bf16_t* x = (const bf16_t*)(F.ws + WS_XB); unsigned char* rt = F.ws + WS_RT; (void)lp;
    LAS int* sel = (LAS int*)F.lds;
    const int lane = F.lane;
    float wg[4][4][8];
#pragma unroll
    for (int j = 0; j < 4; ++j)
#pragma unroll
        for (int q = 0; q < 4; ++q) { const int c = 4 * lane + 256 * j + q; const float g = gain[c]; const f32x4 a = *(const f32x4*)(wr + (size_t)c * 8), b = *(const f32x4*)(wr + (size_t)c * 8 + 4);
            wg[j][q][0] = g * a[0]; wg[j][q][1] = g * a[1]; wg[j][q][2] = g * a[2]; wg[j][q][3] = g * a[3]; wg[j][q][4] = g * b[0]; wg[j][q][5] = g * b[1]; wg[j][q][6] = g * b[2]; wg[j][q][7] = g * b[3]; }
    for (int chunk = F.vcu; chunk < NTOK / 128; chunk += F.G) { const int tok0 = chunk * 128;
        u32x2 xn[4];
#pragma unroll
        for (int j = 0; j < 4; ++j) xn[j] = ((const u32x2*)(x + (size_t)(tok0 + F.wave * 16) * DM))[lane + 64 * j];
        for (int tk = 0; tk < 16; ++tk) { const int tl = F.wave * 16 + tk, token = tok0 + tl;
            u32x2 xr[4]; float s = 0.f, lg[8];
#pragma unroll
            for (int j = 0; j < 4; ++j) xr[j] = xn[j];
            if (tk < 15) {
#pragma unroll
                for (int j = 0; j < 4; ++j) xn[j] = ((const u32x2*)(x + (size_t)(token + 1) * DM))[lane + 64 * j]; }
#pragma unroll
            for (int e = 0; e < 8; ++e) lg[e] = 0.f;
#pragma unroll
            for (int j = 0; j < 4; ++j) { const f32x4 v = bf4(xr[j]); s += (v[0] * v[0] + v[1] * v[1]) + (v[2] * v[2] + v[3] * v[3]);
#pragma unroll
                for (int q = 0; q < 4; ++q)
#pragma unroll
                    for (int e = 0; e < 8; ++e) lg[e] += v[q] * wg[j][q][e]; }
            s = wave_sum(s); const float r = 1.0f / sqrtf(s * (1.0f / DM) + RMS_EPS);
#pragma unroll
            for (int e = 0; e < 8; ++e) lg[e] = wave_sum(lg[e]) * r;
            int i0 = 0; float v0 = lg[0];
#pragma unroll
            for (int e = 1; e < 8; ++e) if (lg[e] > v0) { v0 = lg[e]; i0 = e; }
            int i1 = -1; float v1 = -3.0e38f;
#pragma unroll
            for (int e = 0; e < 8; ++e) if (e != i0 && lg[e] > v1) { v1 = lg[e]; i1 = e; }
            const float g0 = 1.0f / (1.0f + expf(v1 - v0)), g1 = 1.0f - g0;
            if (lane == 0) { sel[2 * tl] = i0; sel[2 * tl + 1] = i1; ((f32x2*)(rt + RT_GATE))[token] = (f32x2){g0, g1}; ((float*)(rt + RT_R))[token] = r; ((int*)(rt + RT_E))[2 * token] = i0; ((int*)(rt + RT_E))[2 * token + 1] = i1; }
        }
        __syncthreads();
        LAS int* wcnt = (LAS int*)(F.lds + 1024);
        int rk = 0, ex = 0;
        if (F.wave < 4) { const int a = F.wave * 64 + lane; ex = sel[a]; int cmine = 0;
#pragma unroll
            for (int ee = 0; ee < 8; ++ee) { const unsigned long long m = __ballot(ex == ee); if (ex == ee) rk = __popcll(m & ((1ull << lane) - 1ull)); if (lane == ee) cmine = __popcll(m); }
            if (lane < 8) wcnt[F.wave * 8 + lane] = cmine; }
        __syncthreads();
        if (F.wave < 4) { int base = 0; for (int w2 = 0; w2 < F.wave; ++w2) base += wcnt[w2 * 8 + ex]; ((int*)(rt + RT_RANK))[2 * tok0 + F.wave * 64 + lane] = base + rk; }
        else if (F.tid < 264) { const int e8 = F.tid - 256; ((int*)(rt + RT_CNTB))[chunk * 8 + e8] = (wcnt[e8] + wcnt[8 + e8]) + (wcnt[16 + e8] + wcnt[24 + e8]); }
        __syncthreads();
    }
}
__device__ __forceinline__ void router_lists(Frame& F, int lp) {
    unsigned char* rt = F.ws + WS_RT; const int* cntb = (const int*)(rt + RT_CNTB);
    int* ltok = (int*)(F.ws + WS_LISTS); float* lgate = (float*)(F.ws + WS_LISTS + MiB); float* lr = (float*)(F.ws + WS_LISTS + 2 * MiB); int* ldst = (int*)(F.ws + WS_LISTS + 3 * MiB);
    LAS int* base = (LAS int*)F.lds;
    for (int chunk = F.vcu; chunk < NTOK / 128; chunk += F.G) { const int tok0 = chunk * 128;
        LAS int* part = (LAS int*)(F.lds + 64);
        if (F.tid < 256) { const int c2 = F.tid; const u32x4 n0 = *(const u32x4*)(cntb + c2 * 8), n1 = *(const u32x4*)(cntb + c2 * 8 + 4);
#pragma unroll
            for (int e = 0; e < 8; ++e) { const int n = (int)(e < 4 ? n0[e] : n1[e - 4]); const float bs = wave_sum((float)((c2 < chunk) ? n : 0)), ts = wave_sum((float)n);
                if (F.lane == 0) { part[F.wave * 16 + e] = (int)bs; part[F.wave * 16 + 8 + e] = (int)ts; } } }
        __syncthreads();
        if (F.tid < 8) { const int e = F.tid; base[e] = (part[e] + part[16 + e]) + (part[32 + e] + part[48 + e]);
            if (chunk == 0) F.ctl[CW_CNT + 64 * lp + e] = (unsigned)((part[8 + e] + part[24 + e]) + (part[40 + e] + part[56 + e])); }
        __syncthreads();
        if (F.tid < 256) { const int a = F.tid, token = tok0 + (a >> 1), k = a & 1; const int e = ((const int*)(rt + RT_E))[2 * token + k], rank = base[e] + ((const int*)(rt + RT_RANK))[2 * tok0 + a], li = e * NTOK + rank;
            ((int*)(rt + RT_RANK))[2 * tok0 + a] = rank; ltok[li] = token; lgate[li] = ((const float*)(rt + RT_GATE))[2 * token + k]; lr[li] = ((const float*)(rt + RT_R))[token]; ldst[li] = 2 * token + k; }
        __syncthreads();
    }
}
__device__ __forceinline__ int expert_tiles_lds(Frame& F, int lp) {
    const unsigned* cnt = F.ctl + CW_CNT + 64 * lp; int acc = 0; LAS int* pt = (LAS int*)(F.lds + MISC_OFF) + 16;
    const int mine = (int)cnt[F.lane & 7];
#pragma unroll
    for (int e = 0; e < 8; ++e) { const int c = __builtin_amdgcn_readlane(mine, e); if (F.tid == 0) { pt[e] = acc; pt[16 + e] = c; } acc += (c + 255) >> 8; }
    if (F.tid == 0) pt[8] = acc;
    __syncthreads();
    return acc;
}
__device__ __forceinline__ void moe_fixup(Frame& F, const pg8::TileMap& tm, int first, int nsplit) {
    const float* part = (const float*)(F.ws + WS_PART); const float* lgate = (const float*)(F.ws + WS_LISTS + MiB); const int* ldst = (const int*)(F.ws + WS_LISTS + 3 * MiB); bf16_t* y = (bf16_t*)(F.ws + WS_Y);
    const LAS int* pt = (const LAS int*)(F.lds + MISC_OFF) + 16;
    const int gw = F.vcu * 8 + F.wave, NGW = F.G * 8, lane = F.lane;
    for (int it = gw; it < nsplit * 256; it += NGW) { const int su = it >> 8, lrow = it & 255; int pm, pn; tm.mapL(first + su, pm, pn); int e = 0;
#pragma unroll
        for (int k = 1; k < 8; ++k) e += (pt[k] <= pm) ? 1 : 0;
        const int rank0 = (pm - pt[e]) * 256, nvalid = pt[16 + e] - rank0; if (lrow >= nvalid) continue;
        const int li = e * NTOK + rank0 + lrow; const float gt = lgate[li]; const int dst = ldst[li];
        const float* p = part + (size_t)(su * 4) * 65536 + (size_t)lrow * 256 + 4 * lane;
        const f32x4 s = ((*(const f32x4*)p + *(const f32x4*)(p + 65536)) + (*(const f32x4*)(p + 2 * 65536) + *(const f32x4*)(p + 3 * 65536))) * gt;
        u32x2 w; w.x = pk2(s[0], s[1]); w.y = pk2(s[2], s[3]); *(u32x2*)(y + (size_t)dst * DM + pn * 256 + 4 * lane) = w; }
}
__device__ __forceinline__ void combine_pass(Frame& F, int lp, const float* gain, bool last) {
    bf16_t* xb = (bf16_t*)(F.ws + WS_XB); const bf16_t* y = (const bf16_t*)(F.ws + WS_Y); float* rq = (float*)(F.ws + WS_RINV) + NTOK;
    const int gw = F.vcu * 8 + F.wave, NGW = F.G * 8, lane = F.lane; (void)lp;
    for (int t0 = gw; t0 < NTOK; t0 += 2 * NGW) {
        const int t1 = (t0 + NGW < NTOK) ? t0 + NGW : t0;
        u32x2 xa[4], ya[4], za[4], xc[4], yc[4], zc[4];
#pragma unroll
        for (int j = 0; j < 4; ++j) { xa[j] = ((const u32x2*)(xb + (size_t)t0 * DM))[lane + 64 * j]; ya[j] = ((const u32x2*)(y + (size_t)(2 * t0) * DM))[lane + 64 * j]; za[j] = ((const u32x2*)(y + (size_t)(2 * t0 + 1) * DM))[lane + 64 * j];
            xc[j] = ((const u32x2*)(xb + (size_t)t1 * DM))[lane + 64 * j]; yc[j] = ((const u32x2*)(y + (size_t)(2 * t1) * DM))[lane + 64 * j]; zc[j] = ((const u32x2*)(y + (size_t)(2 * t1 + 1) * DM))[lane + 64 * j]; }
#pragma unroll
        for (int q = 0; q < 2; ++q) { const int token = q ? t1 : t0; f32x4 v[4]; float s = 0.f;
#pragma unroll
            for (int j = 0; j < 4; ++j) { const f32x4 t = q ? (bf4(xc[j]) + bf4(yc[j]) + bf4(zc[j])) : (bf4(xa[j]) + bf4(ya[j]) + bf4(za[j])); v[j] = t; s += (t[0] * t[0] + t[1] * t[1]) + (t[2] * t[2] + t[3] * t[3]); }
            const float r = 1.0f / sqrtf(wave_sum(s) * (1.0f / DM) + RMS_EPS);
            if (last) { f32x4* orow = (f32x4*)(F.xo + (size_t)token * DM) + lane;
#pragma unroll
                for (int j = 0; j < 4; ++j) orow[64 * j] = v[j] * r * ((const f32x4*)gain)[lane + 64 * j]; }
            else { u32x2* xr = (u32x2*)(xb + (size_t)token * DM) + lane;
#pragma unroll
                for (int j = 0; j < 4; ++j) { u32x2 w; w.x = pk2(v[j][0], v[j][1]); w.y = pk2(v[j][2], v[j][3]); xr[64 * j] = w; }
                if (lane == 0) rq[token] = r; } }
    }
}

constexpr int NPH = 19;
enum { PH_PRE = 0, PH_QKV0, PH_ATT0, PH_MRG0, PH_QKV1, PH_ATT1, PH_MRG1, PH_WO, PH_RINV, PH_DGU, PH_DDOWN, PH_PPREP, PH_PGEMM, PH_ROUTE, PH_RLIST, PH_MGU, PH_MDOWN, PH_MFIX, PH_COMB };

__global__ void __launch_bounds__(512, 2) fwd(Args args) {
    extern __shared__ __attribute__((aligned(16))) unsigned char lds_raw[];
    LAS unsigned char* const lds = (LAS unsigned char*)lds_raw;
    const int wv = __builtin_amdgcn_readfirstlane((int)threadIdx.x >> 6);
    for (int u = threadIdx.x; u < (LDS_BYTES - RING_BYTES) / 4; u += 512) ((LAS unsigned*)(lds + RING_BYTES))[u] = 0u;
    __syncthreads();
    XcdBarrier bar = xcd_barrier_post((unsigned*)(args.ws + WS_CTL) + CW_BAR + args.li * XCD_BAR_WORDS, (volatile LAS unsigned*)(lds + MISC_OFF) + 8);
    const int lo = args.ph_lo, hi = args.ph_hi;
#define FRAME() Frame F; build_frame(F, lds, wv); unsigned char* ws = F.ws; bf16_t* XB = (bf16_t*)(ws + WS_XB); (void)XB

#if PROBE
    if (blockIdx.x == 0 && threadIdx.x == 0) { ((unsigned long long*)(args.ws + WS_SNAP))[0] = __builtin_amdgcn_s_memrealtime(); }
    if (blockIdx.x == PROBE_BLK && threadIdx.x == 0) { for (int k = 64; k < 72; ++k) ((unsigned long long*)(args.ws + WS_SNAP))[k] = 0ull; }
#endif
    for (int lp = 0; lp < 2; ++lp) {
#define PHID(k) (lp * NPH + (k))
#ifndef PHMASK
#define PHMASK 0xfffff
#endif
#define IN(k) (((PHMASK >> ((k) >= PH_QKV1 && (k) <= PH_MRG1 ? (k) - 3 : (k))) & 1) && lo <= PHID(k) && PHID(k) < hi)
#if PROBE
#define SEAM(k) do { if (PHID(k) + 1 < hi) xcd_barrier(bar, wv == 0 && lane_id() == 0); if (blockIdx.x == 0 && threadIdx.x == 0) ((unsigned long long*)(args.ws + WS_SNAP))[PHID(k) + 1] = __builtin_amdgcn_s_memrealtime(); } while (0)
#else
#define SEAM(k) do { if (PHID(k) + 1 < hi) xcd_barrier(bar, wv == 0 && lane_id() == 0); } while (0)
#endif
        if (lp == 0 && IN(PH_PRE)) { FRAME(); convert_static(F); convert_moe(F, 0); rope_table(F); cast_rows(F); SEAM(PH_PRE); }
        for (int hb = 0; hb < 2; ++hb) {
            if (IN(PH_QKV0 + 3 * hb)) { FRAME();
                if (hb == 1) merge_half(F, 0);
                pg8::SchedPlain S; S.tm.init(HTOK / 256, NQKV / 256, F.G, (int)blockIdx.x); S.A = (const char*)(XB + (size_t)hb * HTOK * DM); S.Bt = (const char*)(ws + WS_WQKV) + (size_t)lp * NQKV * DM * 2; S.atile = 256 * DM * 2; S.btile = 256 * DM * 2;
                pg8::EpiQKV E{(bf16_t*)(ws + WS_QKVB), (const float*)(ws + WS_ROPE), (const float*)(ws + WS_RINV) + NTOK + (size_t)hb * HTOK};
                pg8::gemm_phase<pg8::EpiQKV, pg8::SchedPlain, true, true>(F.lds, pg8::Gemm{DM, DM, DM}, S, E, F.tid);
                SEAM(PH_QKV0 + 3 * hb);
            }
            if (IN(PH_ATT0 + 3 * hb)) { FRAME(); att::attn_phase(F.lds, (const bf16_t*)(ws + WS_QKVB), (bf16_t*)(ws + WS_OPART), (float*)(ws + WS_LSE), F.G, (int)blockIdx.x, F.tid); SEAM(PH_ATT0 + 3 * hb); }
            if (hb == 1 && IN(PH_MRG1)) { FRAME(); merge_half(F, 1); SEAM(PH_MRG1); }
        }
        if (IN(PH_WO)) { FRAME();
            pg8::SchedPlain S; S.tm.init(NTOK / 256, DM / 256, F.G, (int)blockIdx.x); S.A = (const char*)(ws + WS_HB); S.Bt = (const char*)(ws + WS_WO) + (size_t)lp * DM * DM * 2; S.atile = 256 * DM * 2; S.btile = 256 * DM * 2;
            pg8::EpiResB<false, true> E{XB, nullptr, (float*)(ws + WS_SSP)};
            pg8::gemm_phase<pg8::EpiResB<false, true>, pg8::SchedPlain, true, true>(F.lds, pg8::Gemm{DM, DM, DM}, S, E, F.tid);
            SEAM(PH_WO);
        }
        if (IN(PH_RINV)) { FRAME(); rinv_pass(F); SEAM(PH_RINV); }
        if (IN(PH_DGU)) { FRAME();
            pg8::SchedPlain S; S.tm.init(NTOK / 256, 2 * DFF / 256, F.G, (int)blockIdx.x); S.A = (const char*)XB; S.Bt = (const char*)(ws + WS_WDGU) + (size_t)lp * 2 * DFF * DM * 2; S.atile = 256 * DM * 2; S.btile = 256 * DM * 2;
            pg8::EpiGU<1> E{(bf16_t*)(ws + WS_ACT), DFF, (const float*)(ws + WS_RINV)};
            pg8::gemm_phase<pg8::EpiGU<1>, pg8::SchedPlain, true, true>(F.lds, pg8::Gemm{DM, DM, DM}, S, E, F.tid);
            SEAM(PH_DGU);
        }
        if (IN(PH_DDOWN)) { FRAME();
            pg8::SchedPlain S; S.tm.init(NTOK / 256, DM / 256, F.G, (int)blockIdx.x); S.A = (const char*)(ws + WS_ACT); S.Bt = (const char*)(ws + WS_WDD) + (size_t)lp * DM * DFF * 2; S.atile = (size_t)256 * DFF * 2; S.btile = (size_t)256 * DFF * 2;
            pg8::EpiResB<false, true> E{XB, nullptr, (float*)(ws + WS_SSP2)};
            pg8::gemm_phase<pg8::EpiResB<false, true>, pg8::SchedPlain, true, true>(F.lds, pg8::Gemm{DFF, DFF, DFF}, S, E, F.tid);
            SEAM(PH_DDOWN);
        }
        if (IN(PH_PPREP)) { FRAME(); pool_prep(F, F.mix_norm + (size_t)(2 * lp + 1) * DM); SEAM(PH_PPREP); }
        if (IN(PH_PGEMM)) { FRAME();
            pg8::SchedPool S; S.tm.init(NTOK / 256, 4, F.G, (int)blockIdx.x); S.A = (const char*)(ws + WS_HB); S.Bt = (const char*)(ws + WS_WPOOL) + (size_t)lp * 4 * 65536 * 2; S.atile = 256 * DM * 2;
            pg8::EpiResB<true, false> E{XB, F.pool_scale + (size_t)lp * DM, nullptr};
            pg8::gemm_phase<pg8::EpiResB<true, false>, pg8::SchedPool, true, true>(F.lds, pg8::Gemm{256, DM, 256}, S, E, F.tid);
            SEAM(PH_PGEMM);
        }
        if (IN(PH_ROUTE)) { FRAME(); router_pass(F, lp, F.ffn_norm + (size_t)(2 * lp + 1) * DM, F.router + (size_t)lp * DM * 8); SEAM(PH_ROUTE); }
        if (IN(PH_RLIST)) { FRAME(); router_lists(F, lp); SEAM(PH_RLIST); }
        if (IN(PH_MGU)) { FRAME();
            pg8::SchedMoe S; S.pt = (const LAS int*)(F.lds + MISC_OFF) + 16; S.toks = (const int*)(ws + WS_LISTS); const int ntile = expert_tiles_lds(F, lp); S.tm.init(ntile, 2 * DFFE / 256, F.G, (int)blockIdx.x);
            S.A = (const char*)XB; S.Bt = (const char*)(ws + WS_WMGU); S.atile = 0; S.btile = 256 * DM * 2; S.estride = (size_t)2 * DFFE * DM * 2;
            pg8::EpiGU<2> E{(bf16_t*)(ws + WS_ACT2), DFFE, (const float*)(ws + WS_LISTS + 2 * MiB)};
            pg8::gemm_phase<pg8::EpiGU<2>, pg8::SchedMoe, true, true, true>(F.lds, pg8::Gemm{DM, DM, DM}, S, E, F.tid);
            SEAM(PH_MGU);
        }
        if (IN(PH_MDOWN)) { FRAME();
            pg8::SchedMoe S; S.pt = (const LAS int*)(F.lds + MISC_OFF) + 16; S.toks = nullptr; const int ntile = expert_tiles_lds(F, lp); S.tm.init(ntile, DM / 256, F.G, (int)blockIdx.x);
            const int full = (ntile * 4) / F.G; S.tm.maxi = full;
            S.A = (const char*)(ws + WS_ACT2); S.Bt = (const char*)(ws + WS_WMD); S.atile = (size_t)256 * DFFE * 2; S.btile = (size_t)256 * DFFE * 2; S.estride = (size_t)DM * DFFE * 2;
            pg8::EpiMoeDown E{(bf16_t*)(ws + WS_Y), (const float*)(ws + WS_LISTS + MiB), (const int*)(ws + WS_LISTS + 3 * MiB)};
            pg8::gemm_phase<pg8::EpiMoeDown, pg8::SchedMoe, true, true>(F.lds, pg8::Gemm{DFFE, DFFE, DFFE}, S, E, F.tid);
            pg8::SchedMoeSplit S2; S2.tm = S.tm; S2.tm.maxi = 0x7fffffff; S2.A = S.A; S2.Bt = S.Bt; S2.atile = S.atile; S2.btile = S.btile; S2.estride = S.estride; S2.pt = S.pt; S2.first = full * F.G; S2.nsplit = ntile * 4 - full * F.G;
            pg8::EpiPart E2{(float*)(ws + WS_PART)};
            pg8::gemm_phase<pg8::EpiPart, pg8::SchedMoeSplit, true, true>(F.lds, pg8::Gemm{DFFE / 4, DFFE, DFFE}, S2, E2, F.tid);
            SEAM(PH_MDOWN);
        }
        if (IN(PH_MFIX)) { FRAME();
            const int ntile = expert_tiles_lds(F, lp); pg8::TileMap tm; tm.init(ntile, DM / 256, F.G, (int)blockIdx.x); const int full = (ntile * 4) / F.G;
            moe_fixup(F, tm, full * F.G, ntile * 4 - full * F.G);
            SEAM(PH_MFIX);
        }
        if (IN(PH_COMB)) { FRAME();
            if (lp == 0) { combine_pass(F, lp, nullptr, false); convert_moe(F, 1); SEAM(PH_COMB); }
            else { combine_pass(F, lp, F.final_norm, true); SEAM(PH_COMB); }
        }
#undef PHID
#undef IN
#undef SEAM
    }
}
#if DEBUG_CHECK
namespace dbg {
__device__ __forceinline__ unsigned hsh(unsigned a) { a ^= a >> 16; a *= 0x7feb352dU; a ^= a >> 15; a *= 0x846ca68bU; a ^= a >> 16; return a; }
__device__ __forceinline__ void report(unsigned* d, int id, float err, float tol) { float ratio = err / tol; if (!(ratio <= 1.f)) { if (!(ratio < 1e30f)) ratio = 1e30f; atomicMax(d + id, __float_as_uint(ratio)); } }
__device__ __forceinline__ float silu(float g) { return g / (1.0f + expf(-g)); }
__device__ __forceinline__ void wdot(const bf16_t* a, const float* w, size_t ldw, int K, const float* gain, int lane, float& dot, float& ad) {
    float s = 0.f, t = 0.f; for (int k = lane; k < K; k += 64) { const float p = bf2f(a[k]) * w[(size_t)k * ldw] * (gain ? gain[k] : 1.f); s += p; t += fabsf(p); } dot = wave_sum(s); ad = wave_sum(t); }
__device__ __forceinline__ float row_r(const float* xrow, int lane) { float s = 0.f; for (int k = lane; k < DM; k += 64) s += xrow[k] * xrow[k]; return 1.0f / sqrtf(wave_sum(s) * (1.0f / DM) + RMS_EPS); }
__device__ __forceinline__ float row_rb(const bf16_t* xrow, int lane) { float s = 0.f; for (int k = lane; k < DM; k += 64) { const float v = bf2f(xrow[k]); s += v * v; } return 1.0f / sqrtf(wave_sum(s) * (1.0f / DM) + RMS_EPS); }
__device__ __forceinline__ void tiles(const unsigned* cnt, int (&pt)[9]) { int acc = 0; for (int q = 0; q < 8; ++q) { pt[q] = acc; acc += ((int)cnt[q] + 255) >> 8; } pt[8] = acc; }

__global__ void snap_pos(const bf16_t* src, float* snap, unsigned salt) { const unsigned k = blockIdx.x * 64 + threadIdx.x; const unsigned h = hsh(k * 2654435761u + salt); snap[k] = bf2f(src[(size_t)(h % NTOK) * DM + (hsh(h) % DM)]); }
__global__ void snap_rows(const bf16_t* src, float* snap, unsigned salt) { const unsigned k = blockIdx.x; const unsigned row = hsh(k * 2654435761u + salt) % NTOK; for (int c = threadIdx.x; c < DM; c += 64) snap[(size_t)k * DM + c] = bf2f(src[(size_t)row * DM + c]); }

__global__ void chk_cast(const float* x, const bf16_t* xb, const float* rq, unsigned* d, int id) {
    const int lane = threadIdx.x; const unsigned row = hsh(blockIdx.x * 2654435761u + 11u) % NTOK; const float r = row_r(x + (size_t)row * DM, lane); float e = 0.f;
    for (int c = lane; c < DM; c += 64) { const float ref = x[(size_t)row * DM + c]; e = fmaxf(e, fabsf(bf2f(xb[(size_t)row * DM + c]) - ref) / (0.005f * fabsf(ref) + 1e-6f)); }
    e = fmaxf(wave_max(e), fabsf(rq[row] - r) / (1e-4f * r)); if (lane == 0) report(d, id, e, 1.f);
}
__global__ void chk_qkv(const bf16_t* xbh, const float* rqh, const float* w, const float* gain, const bf16_t* qkvb, unsigned* d, int id) {
    const int lane = threadIdx.x; const unsigned hh = hsh(blockIdx.x * 2654435761u + 23u); const int row = hh % HTOK, c = hsh(hh) % NQKV;
    const int g = c / 3072, t = (c % 3072) >> 10, h = (c & 1023) >> 6, dd = c & 63, dsh = 2 * g, Lg = SEQ >> dsh;
    const int s = row & 2047, bl = row >> 11, r = s & ((1 << dsh) - 1), j = s >> dsh, seq = ((bl << dsh) + r) * NHEAD + h; const float rf = rqh[row];
    float ref, tol; int pos;
    if (t < 2) { const int dlo = dd & 31, cb = c - dd; float tlo, thi, a0, a1; wdot(xbh + (size_t)row * DM, w + cb + dlo, NQKV, DM, gain, lane, tlo, a0); wdot(xbh + (size_t)row * DM, w + cb + dlo + 32, NQKV, DM, gain, lane, thi, a1);
        tlo *= rf; thi *= rf; a0 *= rf; a1 *= rf;
        const float ang = (float)s * powf(10000.0f, -(float)(2 * dlo) / 64.0f), cs = cosf(ang), sn = sinf(ang); const float olo = tlo * cs - thi * sn, ohi = thi * cs + tlo * sn;
        ref = dd < 32 ? olo : ohi; tol = 0.01f * (a0 + a1) + 2e-3f; if (t == 0) { ref *= QSCALE; tol *= QSCALE; tol += 1e-3f; } pos = dd < 32 ? 2 * dlo : 2 * dlo + 1; }
    else { float a0; wdot(xbh + (size_t)row * DM, w + c, NQKV, DM, gain, lane, ref, a0); ref *= rf; tol = 0.01f * a0 * rf + 2e-3f; pos = dd; }
    const float got = bf2f(qkvb[(size_t)(g * 3 + t) * ((size_t)HTOK * DM) + ((size_t)seq * Lg + j) * HDIM + pos]);
    if (lane == 0) report(d, id, fabsf(got - ref), tol);
}
__global__ void chk_attn(const bf16_t* qkvb, const bf16_t* opart, const float* lse, unsigned* d, int id) {
    const int lane = threadIdx.x; const unsigned hh = hsh(blockIdx.x * 2654435761u + 37u); const int g = blockIdx.x % 3, dsh = 2 * g, Lg = SEQ >> dsh, nseq = (HTOK * NHEAD) / Lg;
    const int seq = hh % nseq; int j = hsh(hh) % Lg; if ((blockIdx.x / 3) % 4 == 0) j = j % 130;
    const size_t GS = (size_t)HTOK * DM; const bf16_t* qb = qkvb + (size_t)(g * 3) * GS + ((size_t)seq * Lg) * HDIM; const bf16_t* kb = qb + GS; const bf16_t* vb = kb + GS;
    float sc[3]; float mx = -1e30f;
    for (int i = 0; i < 3; ++i) { const int kk = lane + 64 * i, jk = j - 128 + kk; sc[i] = -1e30f;
        if (kk <= 128 && jk >= 0) { float s = 0.f; for (int e = 0; e < 64; ++e) s += bf2f(qb[(size_t)j * 64 + e]) * bf2f(kb[(size_t)jk * 64 + e]); sc[i] = s; } mx = fmaxf(mx, sc[i]); }
    mx = wave_max(mx); float l = 0.f, p[3];
    for (int i = 0; i < 3; ++i) { p[i] = sc[i] > -1e29f ? exp2f(sc[i] - mx) : 0.f; l += p[i]; }
    l = wave_sum(l);
    const int h = seq & 15, br = seq >> 4, bl = br >> dsh, r = br & ((1 << dsh) - 1); const size_t tokrow = (size_t)bl * SEQ + ((size_t)j << dsh) + r;
    float e = 0.f;
    for (int dd = 0; dd < 64; ++dd) { float o = 0.f; for (int i = 0; i < 3; ++i) { const int kk = lane + 64 * i, jk = j - 128 + kk; if (p[i] > 0.f) o += p[i] * bf2f(vb[(size_t)jk * 64 + dd]); }
        o = wave_sum(o) / l; const float got = bf2f(opart[(size_t)g * GS + tokrow * DM + h * 64 + dd]); e = fmaxf(e, fabsf(got - o) / (0.02f * fabsf(o) + 0.02f)); }
    const float lref = mx + log2f(l), lgot = lse[(size_t)g * ((size_t)HTOK * NHEAD) + tokrow * NHEAD + h]; e = fmaxf(e, fabsf(lref - lgot) / 0.02f);
    if (lane == 0) report(d, id, e, 1.f);
}
__global__ void chk_merge(const bf16_t* opart, const float* lse, const bf16_t* hbh, unsigned* d, int id) {
    const int lane = threadIdx.x; const unsigned hh = hsh(blockIdx.x * 2654435761u + 41u); const int row = hh % HTOK; float e = 0.f;
    for (int c = lane; c < DM; c += 64) { const int h = c >> 6; float l[3], w[3], mx = -1e30f, sum = 0.f, o = 0.f;
        for (int g = 0; g < 3; ++g) { l[g] = lse[(size_t)g * ((size_t)HTOK * NHEAD) + (size_t)row * NHEAD + h]; mx = fmaxf(mx, l[g]); }
        for (int g = 0; g < 3; ++g) { w[g] = exp2f(l[g] - mx); sum += w[g]; }
        for (int g = 0; g < 3; ++g) o += w[g] / sum * bf2f(opart[(size_t)g * ((size_t)HTOK * DM) + (size_t)row * DM + c]);
        e = fmaxf(e, fabsf(bf2f(hbh[(size_t)row * DM + c]) - o) / (0.01f * fabsf(o) + 5e-3f)); }
    e = wave_max(e); if (lane == 0) report(d, id, e, 1.f);
}
__global__ void chk_res(const bf16_t* xb, const float* snap, unsigned salt, const bf16_t* A, int lda, int K, const float* W, int ldw, int wsel, const float* scale, unsigned* d, int id) {
    const int lane = threadIdx.x; const unsigned k = blockIdx.x; const unsigned h = hsh(k * 2654435761u + salt); const int row = h % NTOK, col = hsh(h) % DM;
    float dot, ad; if (wsel == 0) wdot(A + (size_t)row * lda, W + col, ldw, K, nullptr, lane, dot, ad); else wdot(A + (size_t)row * lda + (col & ~255), W + (size_t)(col >> 8) * 65536 + (col & 255), 256, 256, nullptr, lane, dot, ad);
    const float sc = scale ? scale[col] : 1.f; const float ref = snap[k] + sc * dot, got = bf2f(xb[(size_t)row * DM + col]);
    if (lane == 0) report(d, id, fabsf(got - ref), 0.01f * fabsf(sc) * ad + 0.005f * fabsf(ref) + 2e-3f);
}
__global__ void chk_ssp(const bf16_t* xb, const float* ssp, unsigned* d, int id) {
    const int lane = threadIdx.x; const unsigned row = hsh(blockIdx.x * 2654435761u + 59u) % NTOK; float s = 0.f;
    for (int c = lane; c < DM; c += 64) { const float v = bf2f(xb[(size_t)row * DM + c]); s += v * v; }
    s = wave_sum(s); float sp = 0.f; if (lane < 16) sp = ssp[(size_t)lane * NTOK + row]; sp = wave_sum(sp);
    if (lane == 0) report(d, id, fabsf(sp - s), 5e-3f * s + 1e-6f);
}
__global__ void chk_gu(const bf16_t* xb, const float* gain, const float* wg, const float* wu, int nff, const bf16_t* act, const unsigned char* rt, const unsigned* cnt, size_t estride, unsigned* d, int id) {
    const int lane = threadIdx.x; const unsigned hh = hsh(blockIdx.x * 2654435761u + 61u); const int token = hh % NTOK; const int j = hsh(hh) % nff; size_t eo = 0; int dest = token;
    const float r = row_rb(xb + (size_t)token * DM, lane);
    if (rt) { const int k = (hh >> 20) & 1; const int ee = ((const int*)(rt + RT_E))[2 * token + k]; int pt[9]; tiles(cnt, pt); eo = (size_t)ee * estride; dest = pt[ee] * 256 + ((const int*)(rt + RT_RANK))[2 * token + k]; }
    float g, u, a0, a1; wdot(xb + (size_t)token * DM, wg + eo + j, nff, DM, gain, lane, g, a0); wdot(xb + (size_t)token * DM, wu + eo + j, nff, DM, gain, lane, u, a1);
    const float ref = silu(g * r) * (u * r), got = bf2f(act[(size_t)dest * nff + j]);
    if (lane == 0) report(d, id, fabsf(got - ref), 0.02f * fabsf(ref) + 0.01f * r * r * (a0 * fabsf(u) + a1 * fabsf(g)) + 5e-3f);
}
__global__ void chk_pprep(const bf16_t* xb, const float* gain, const bf16_t* pa, unsigned* d, int id) {
    const int lane = threadIdx.x; const unsigned hh = hsh(blockIdx.x * 2654435761u + 67u); int row = hh % NTOK; const int c = hsh(hh) % DM; if (blockIdx.x % 4 == 0) row = (row & ~2047) + (row & 15);
    const int t = row & 2047, g = c >> 8, P = 2 << g, lo = (t + 1 - P) > 0 ? (t + 1 - P) : 0; float sum = 0.f, cur = 0.f;
    for (int tt = lo; tt <= t; ++tt) { const bf16_t* xr = xb + (size_t)(row - t + tt) * DM; const float hn = bf2f(xr[c]) * row_rb(xr, lane) * gain[c]; sum += hn; cur = hn; }
    const float ref = sum / (float)(t + 1 - lo) - cur, got = bf2f(pa[(size_t)row * DM + c]);
    if (lane == 0) report(d, id, fabsf(got - ref), 0.01f * fabsf(ref) + 0.01f * fabsf(cur) + 2e-3f);
}
__global__ void chk_route(const bf16_t* xb, const float* gain, const float* wr, const unsigned char* rt, const unsigned* cnt, const int* ltok, const float* lgate, const float* lr, unsigned* d, int id) {
    const int lane = threadIdx.x; const unsigned token = hsh(blockIdx.x * 2654435761u + 71u) % NTOK; const bf16_t* xr = xb + (size_t)token * DM; const float r = row_rb(xr, lane);
    float lg[8]; for (int e = 0; e < 8; ++e) { float s = 0.f; for (int c = lane; c < DM; c += 64) s += bf2f(xr[c]) * r * gain[c] * wr[(size_t)c * 8 + e]; lg[e] = wave_sum(s); }
    int i0 = 0; for (int e = 1; e < 8; ++e) if (lg[e] > lg[i0]) i0 = e; int i1 = -1; for (int e = 0; e < 8; ++e) if (e != i0 && (i1 < 0 || lg[e] > lg[i1])) i1 = e;
    float third = -1e30f; for (int e = 0; e < 8; ++e) if (e != i0 && e != i1) third = fmaxf(third, lg[e]);
    const int* re = (const int*)(rt + RT_E); const int* rk = (const int*)(rt + RT_RANK); const float* rg = (const float*)(rt + RT_GATE);
    float e = 0.f; const bool clear = (lg[i0] - lg[i1] > 1e-3f) && (lg[i1] - third > 1e-3f);
    if (clear) { if (re[2 * token] != i0 || re[2 * token + 1] != i1) e = 1e6f; const float g0 = 1.0f / (1.0f + expf(lg[i1] - lg[i0])); e = fmaxf(e, fabsf(rg[2 * token] - g0) / 2e-3f); e = fmaxf(e, fabsf(rg[2 * token + 1] - (1.f - g0)) / 2e-3f); }
    for (int k = 0; k < 2; ++k) { const int ee = re[2 * token + k], rank = rk[2 * token + k]; if (ee < 0 || ee > 7 || rank < 0 || rank >= (int)cnt[ee]) { e = 2e6f; continue; }
        const size_t li = (size_t)ee * NTOK + rank; if (ltok[li] != (int)token) e = fmaxf(e, 3e6f); if (fabsf(lgate[li] - rg[2 * token + k]) > 1e-6f) e = fmaxf(e, 4e6f); e = fmaxf(e, fabsf(lr[li] - r) / (1e-4f * r)); }
    if (lane == 0) report(d, id, e, 1.f);
}
__global__ void chk_mdown(const bf16_t* act2, const float* md, const bf16_t* y, const unsigned char* rt, const unsigned* cnt, unsigned* d, int id) {
    const int lane = threadIdx.x; const unsigned hh = hsh(blockIdx.x * 2654435761u + 73u); const int token = hh % NTOK, col = hsh(hh) % DM, k = (hh >> 20) & 1;
    int pt[9]; tiles(cnt, pt); const int ee = ((const int*)(rt + RT_E))[2 * token + k], ds = pt[ee] * 256 + ((const int*)(rt + RT_RANK))[2 * token + k]; const float gt = ((const float*)(rt + RT_GATE))[2 * token + k];
    float dot, ad; wdot(act2 + (size_t)ds * DFFE, md + (size_t)ee * DFFE * DM + col, DM, DFFE, nullptr, lane, dot, ad);
    if (lane == 0) report(d, id, fabsf(bf2f(y[(size_t)(2 * token + k) * DM + col]) - gt * dot), 0.01f * gt * ad + 0.01f * fabsf(gt * dot) + 2e-3f);
}
__global__ void chk_comb(const float* out, const bf16_t* xb, const float* rq, const float* snaprows, unsigned salt, const bf16_t* y, const unsigned char* rt, const unsigned* cnt, const float* gain, int last, unsigned* d, int id) {
    const int lane = threadIdx.x; const unsigned k = blockIdx.x; const unsigned token = hsh(k * 2654435761u + salt) % NTOK; (void)cnt; (void)rt;
    const int d0 = 2 * token, d1 = 2 * token + 1; float s = 0.f;
    for (int c = lane; c < DM; c += 64) { const float v = snaprows[(size_t)k * DM + c] + bf2f(y[(size_t)d0 * DM + c]) + bf2f(y[(size_t)d1 * DM + c]); s += v * v; }
    const float r = 1.0f / sqrtf(wave_sum(s) * (1.0f / DM) + RMS_EPS); float e = 0.f;
    for (int c = lane; c < DM; c += 64) { const float v = snaprows[(size_t)k * DM + c] + bf2f(y[(size_t)d0 * DM + c]) + bf2f(y[(size_t)d1 * DM + c]);
        if (last) { const float n = v * r * gain[c]; e = fmaxf(e, fabsf(out[(size_t)token * DM + c] - n) / (1e-3f * fabsf(n) + 1e-4f)); }
        else e = fmaxf(e, fabsf(bf2f(xb[(size_t)token * DM + c]) - v) / (0.005f * fabsf(v) + 1e-5f)); }
    e = wave_max(e); if (!last) e = fmaxf(e, fabsf(rq[token] - r) / (1e-3f * r)); if (lane == 0) report(d, id, e, 1.f);
}
__global__ void report_out(float* out, int n, const unsigned* d, const unsigned* tmo) {
    int id = -1; for (int k = 0; k < 64; ++k) if (d[k] != 0u) { id = k; break; }
    if (id < 0 && tmo[XB_TMO] != 0u) id = 63;
    if (id < 0) return;
    const float c = sqrtf(1.01f * (float)(10 + id)) * 10.f;
    for (int i = blockIdx.x * blockDim.x + threadIdx.x; i < n; i += gridDim.x * blockDim.x) out[i] = c;
}
}
#endif

#if PROBE
#ifndef PROBE_SC
#define PROBE_SC 10.0f
#define PROBE_OFF 10.0f
#endif
__global__ void probe_out(float* out, const unsigned long long* ts, unsigned long long maskA, unsigned long long maskB) {
    float d1 = 0.f, d2 = 0.f;
#ifdef PROBE_SEG
    d1 = (float)ts[64 + PROBE_SEG] * 0.01f;
#else
    for (int k = 0; k < 2 * NPH; ++k) { if (k == NPH) continue; const unsigned long long t1 = ts[k + 1], t0 = (k == NPH + 1) ? ts[NPH] : ts[k]; const float us = (float)(t1 - t0) * 0.01f;     if ((maskA >> k) & 1ull) d1 += us; if ((maskB >> k) & 1ull) d2 += us; }
#endif
    const float V = PROBE_SC * logf(fmaxf(d1, 3.f)) - PROBE_OFF;
    if (blockIdx.x == 0 && threadIdx.x == 0) out[(size_t)NTOK * DM - 1] = V + 0.f * d2;
}
#ifndef PROBE_A
#define PROBE_A 1ull
#endif
#ifndef PROBE_SC
#define PROBE_SC 10.0f
#define PROBE_OFF 10.0f
#endif
#ifndef PROBE_B
#define PROBE_B 1ull
#endif
#endif
extern "C" void kernel_launch(void* const* d_in, const int* in_sizes, int n_in, void* d_out, int out_size, void* d_ws, size_t ws_size, hipStream_t stream) {
    static int grid = 0;
    if (grid == 0) {
        if (n_in != 15 || out_size != NTOK * DM || ws_size < WS_END + (DEBUG_CHECK ? 4 * MiB : 0)) { fprintf(stderr, "kernel_launch: unexpected shapes / workspace (%d inputs, out %d, ws %zu)\n", n_in, out_size, ws_size); grid = -1; return; }
        int dev = 0, cus = 0, per_cu = 0;
        if (hipGetDevice(&dev) != hipSuccess || hipDeviceGetAttribute(&cus, hipDeviceAttributeMultiprocessorCount, dev) != hipSuccess) { grid = -1; return; }
        if (hipFuncSetAttribute((const void*)fwd, hipFuncAttributeMaxDynamicSharedMemorySize, LDS_BYTES) != hipSuccess) { grid = -1; return; }
        if (hipOccupancyMaxActiveBlocksPerMultiprocessor(&per_cu, (const void*)fwd, 512, LDS_BYTES) != hipSuccess || per_cu < 1) fprintf(stderr, "kernel_launch: occupancy query reports %d\n", per_cu);
        (void)hipGetLastError();
        grid = cus;
    }
    if (grid < 0) return;
    (void)hipMemsetAsync((char*)d_ws + WS_CTL, 0, CTL_ZERO_BYTES, stream);
    Args a{};
    for (int i = 0; i < 15; ++i) a.in[i] = (const float*)d_in[i];
    a.out = (float*)d_out; a.ws = (unsigned char*)d_ws;
#if !DEBUG_CHECK
    a.ph_lo = 0; a.ph_hi = 2 * NPH; a.li = 0; a.pad = 0;
    hipLaunchKernelGGL(fwd, dim3(grid), dim3(512), LDS_BYTES, stream, a);
#if TWICE
    (void)hipMemsetAsync((char*)d_ws + WS_CTL, 0, CTL_ZERO_BYTES, stream);
    hipLaunchKernelGGL(fwd, dim3(grid), dim3(512), LDS_BYTES, stream, a);
#endif
#if PROBE
    probe_out<<<256, 256, 0, stream>>>((float*)d_out, (const unsigned long long*)((unsigned char*)d_ws + WS_SNAP), PROBE_A, PROBE_B);
#endif
#else
    unsigned char* ws = (unsigned char*)d_ws; unsigned* ctl = (unsigned*)ws; unsigned* D = ctl + CW_DBG; float* xo = (float*)d_out;
    float* snap = (float*)(ws + WS_SNAP); float* snaprows = (float*)(ws + WS_SNAP + 1 * MiB);
    const float* const* in = (const float* const*)d_in; unsigned char* rt = ws + WS_RT;
    const bf16_t* XB = (const bf16_t*)(ws + WS_XB); const bf16_t* HB = (const bf16_t*)(ws + WS_HB); const float* RQ = (const float*)(ws + WS_RINV) + NTOK;
    constexpr int NS = 256;
    for (int ph = 0; ph < 2 * NPH; ++ph) {
        const int lp = ph / NPH, k = ph % NPH; if (lp == 1 && k == PH_PRE) continue;
        const int cid = 20 * lp; const unsigned salt = 1000u + ph; const unsigned* cnt = ctl + CW_CNT + 64 * lp;
        if (k == PH_WO || k == PH_DDOWN || k == PH_PGEMM) dbg::snap_pos<<<NS / 64, 64, 0, stream>>>(XB, snap, salt);
        if (k == PH_COMB) dbg::snap_rows<<<64, 64, 0, stream>>>(XB, snaprows, salt);
        a.ph_lo = ph; a.ph_hi = ph + 1; a.li = ph; a.pad = 0;
        hipLaunchKernelGGL(fwd, dim3(grid), dim3(512), LDS_BYTES, stream, a);
        if (k == PH_PRE) dbg::chk_cast<<<64, 64, 0, stream>>>(in[0], XB, RQ, D, 1);
        if (k == PH_QKV0 || k == PH_QKV1) { const size_t ho = (size_t)(k == PH_QKV1) * HTOK; dbg::chk_qkv<<<NS, 64, 0, stream>>>(XB + ho * DM, RQ + ho, in[3] + (size_t)lp * DM * NQKV, in[1] + (size_t)(2 * lp) * DM, (const bf16_t*)(ws + WS_QKVB), D, cid + (k == PH_QKV0 ? 2 : 3)); }
        if (k == PH_ATT0 || k == PH_ATT1) dbg::chk_attn<<<NS * 3, 64, 0, stream>>>((const bf16_t*)(ws + WS_QKVB), (const bf16_t*)(ws + WS_OPART), (const float*)(ws + WS_LSE), D, cid + 4);
        if (k == PH_QKV1 || k == PH_MRG1) dbg::chk_merge<<<64, 64, 0, stream>>>((const bf16_t*)(ws + WS_OPART), (const float*)(ws + WS_LSE), HB + (size_t)(k == PH_MRG1) * HTOK * DM, D, cid + 5);
        if (k == PH_WO) { dbg::chk_res<<<NS, 64, 0, stream>>>(XB, snap, salt, HB, DM, DM, in[4] + (size_t)lp * DM * DM, DM, 0, nullptr, D, cid + 6);
            dbg::chk_ssp<<<64, 64, 0, stream>>>(XB, (const float*)(ws + WS_SSP), D, cid + 6); }
        if (k == PH_DGU) dbg::chk_gu<<<NS, 64, 0, stream>>>(XB, in[2] + (size_t)(2 * lp) * DM, in[7] + (size_t)lp * DM * DFF, in[8] + (size_t)lp * DM * DFF, DFF, (const bf16_t*)(ws + WS_ACT), nullptr, nullptr, 0, D, cid + 7);
        if (k == PH_DDOWN) { dbg::chk_res<<<NS, 64, 0, stream>>>(XB, snap, salt, (const bf16_t*)(ws + WS_ACT), DFF, DFF, in[9] + (size_t)lp * DFF * DM, DM, 0, nullptr, D, cid + 8);
            dbg::chk_ssp<<<64, 64, 0, stream>>>(XB, (const float*)(ws + WS_SSP2), D, cid + 8); }
        if (k == PH_PPREP) dbg::chk_pprep<<<NS, 64, 0, stream>>>(XB, in[1] + (size_t)(2 * lp + 1) * DM, HB, D, cid + 9);
        if (k == PH_PGEMM) dbg::chk_res<<<NS, 64, 0, stream>>>(XB, snap, salt, HB, DM, 256, in[5] + (size_t)lp * 4 * 65536, 256, 1, in[6] + (size_t)lp * DM, D, cid + 10);
        if (k == PH_RLIST) dbg::chk_route<<<NS, 64, 0, stream>>>(XB, in[2] + (size_t)(2 * lp + 1) * DM, in[10] + (size_t)lp * DM * 8, rt, cnt, (const int*)(ws + WS_LISTS), (const float*)(ws + WS_LISTS + MiB), (const float*)(ws + WS_LISTS + 2 * MiB), D, cid + 11);
        if (k == PH_MGU) dbg::chk_gu<<<NS, 64, 0, stream>>>(XB, in[2] + (size_t)(2 * lp + 1) * DM, in[11] + (size_t)lp * 8 * DM * DFFE, in[12] + (size_t)lp * 8 * DM * DFFE, DFFE, (const bf16_t*)(ws + WS_ACT2), rt, cnt, (size_t)DM * DFFE, D, cid + 12);
        if (k == PH_MFIX) dbg::chk_mdown<<<NS, 64, 0, stream>>>((const bf16_t*)(ws + WS_ACT2), in[13] + (size_t)lp * 8 * DFFE * DM, (const bf16_t*)(ws + WS_Y), rt, cnt, D, cid + 13);
        if (k == PH_COMB) dbg::chk_comb<<<64, 64, 0, stream>>>(xo, XB, RQ, snaprows, salt, (const bf16_t*)(ws + WS_Y), rt, cnt, in[14], lp == 1, D, cid + 14);
    }
    dbg::report_out<<<1024, 256, 0, stream>>>(xo, out_size, D, ctl + CW_BAR);
#endif
}
```

```cpp
#include <hip/hip_runtime.h>
#include <cstdio>
#include <cstdint>

#ifndef DEBUG_CHECK
#define DEBUG_CHECK 0
#endif
#ifndef PROBE
#define PROBE 0
#endif
#ifndef TWICE
#define TWICE 0
#endif
#ifndef PROBE_BLK
#define PROBE_BLK 0
#define PROBE_WAVE 0
#endif

#define LAS __attribute__((address_space(3)))
#define GAS __attribute__((address_space(1)))
typedef unsigned short bf16_t;
typedef short bf16x8 __attribute__((ext_vector_type(8)));
typedef short s16x4 __attribute__((ext_vector_type(4)));
typedef float f32x4 __attribute__((ext_vector_type(4)));
typedef float f32x2 __attribute__((ext_vector_type(2)));
typedef unsigned u32x4 __attribute__((ext_vector_type(4)));
typedef unsigned u32x2 __attribute__((ext_vector_type(2)));

constexpr int NTOK = 32768, DM = 1024, SEQ = 2048, NHEAD = 16, HDIM = 64;
constexpr int NQKV = 9216, DFF = 2816, DFFE = 3584, NEXP = 8;
constexpr int HTOK = 16384;
constexpr float RMS_EPS = 1e-6f;
constexpr float QSCALE = 0.125f * 1.4426950408889634f;
constexpr int RING_BYTES = 131072, MISC_OFF = RING_BYTES + 320, LDS_BYTES = 149504;
constexpr int TOK_OFF = RING_BYTES + 1024;
constexpr int MAXSLOT = 67584;

constexpr size_t MiB = 1u << 20;
constexpr size_t WS_CTL = 0, CTL_ZERO_BYTES = 1 * MiB;
constexpr size_t WS_ROPE = 1 * MiB;
constexpr size_t WS_SSP = 2 * MiB;
constexpr size_t WS_RT = 4 * MiB;
constexpr size_t RT_E = 0, RT_RANK = 256 * 1024, RT_GATE = 512 * 1024, RT_R = 768 * 1024, RT_CNTB = 1024 * 1024;
constexpr size_t WS_SSP2 = 6 * MiB;
constexpr size_t WS_RINV = 8 * MiB;
constexpr size_t WS_WQKV = 10 * MiB, WS_WO = 46 * MiB, WS_WPOOL = 50 * MiB, WS_WDGU = 51 * MiB, WS_WDD = 73 * MiB, WS_WMGU = 84 * MiB, WS_WMD = 196 * MiB;
constexpr size_t WS_XB = 252 * MiB;
constexpr size_t WS_HB = 316 * MiB;
constexpr size_t WS_QKVB = 380 * MiB;
constexpr size_t WS_OPART = 668 * MiB;
constexpr size_t WS_LSE = 764 * MiB;
constexpr size_t WS_ACT = 380 * MiB;
constexpr size_t WS_Y = 316 * MiB;
constexpr size_t WS_ACT2 = 448 * MiB;
constexpr size_t WS_LISTS = 910 * MiB;
constexpr size_t WS_PART = 916 * MiB;
constexpr size_t WS_END = 944 * MiB;
constexpr size_t WS_SNAP = 945 * MiB;
constexpr int CW_CNT = 1024;
constexpr int CW_DBG = 2048;
constexpr int CW_BAR = 4096;

__device__ __forceinline__ unsigned f2bf(float f) { unsigned u = __builtin_bit_cast(unsigned, f); return (u + 0x7fffu + ((u >> 16) & 1u)) >> 16; }
__device__ __forceinline__ unsigned pk2(float lo, float hi) { return f2bf(lo) | (f2bf(hi) << 16); }
__device__ __forceinline__ float bf2f(unsigned short b) { return __builtin_bit_cast(float, (unsigned)b << 16); }
__device__ __forceinline__ unsigned cvt_pk_bf16(float lo, float hi) { unsigned r; asm volatile("v_cvt_pk_bf16_f32 %0, %1, %2" : "=v"(r) : "v"(lo), "v"(hi)); return r; }
template <int CTRL> __device__ __forceinline__ float dpp_mov(float v) { return __builtin_bit_cast(float, __builtin_amdgcn_update_dpp(0, __builtin_bit_cast(int, v), CTRL, 0xF, 0xF, true)); }
__device__ __forceinline__ float wave_sum(float v) {
    v += dpp_mov<0xB1>(v); v += dpp_mov<0x4E>(v); v += dpp_mov<0x141>(v); v += dpp_mov<0x140>(v);
    auto r = __builtin_amdgcn_permlane16_swap(__float_as_uint(v), __float_as_uint(v), false, false); v = __uint_as_float(r[0]) + __uint_as_float(r[1]);
    auto q = __builtin_amdgcn_permlane32_swap(__float_as_uint(v), __float_as_uint(v), false, false); return __uint_as_float(q[0]) + __uint_as_float(q[1]);
}
__device__ __forceinline__ float wave_max(float v) {
#pragma unroll
    for (int o = 1; o < 64; o <<= 1) v = fmaxf(v, __shfl_xor(v, o));
    return v;
}
__device__ __forceinline__ int lane_id() { int l; asm volatile("v_mbcnt_lo_u32_b32 %0, -1, 0\n\tv_mbcnt_hi_u32_b32 %0, -1, %0" : "=v"(l)); return l; }
#define LDS_WAIT() asm volatile("s_waitcnt lgkmcnt(0)" ::: "memory")
#define VM_WAIT() asm volatile("s_waitcnt vmcnt(0)" ::: "memory")

#define XB_TMO      128
#define XB_XCNT(j)  (256  + 64 * (j))
#define XB_XSUB(j)  (1280 + 64 * (j))
#define XB_XGEN(j)  (2304 + 64 * (j))
#define XB_TOP      3328
#define XB_TOPGEN   3392
#define XCD_BAR_WORDS 3456
#define XB_SPIN_CAP (1u << 22)
__device__ __forceinline__ unsigned xb_ld(unsigned* p)              { return __hip_atomic_load(p, __ATOMIC_RELAXED, __HIP_MEMORY_SCOPE_AGENT); }
__device__ __forceinline__ unsigned xb_add(unsigned* p, unsigned v) { return __hip_atomic_fetch_add(p, v, __ATOMIC_RELAXED, __HIP_MEMORY_SCOPE_AGENT); }
__device__ __forceinline__ unsigned xb_xcc_id() { return (unsigned)__builtin_amdgcn_s_getreg((3 << 11) | 20) & 0xFu; }
#define XB_SPIN(cond, bar) do { unsigned _sp = 0; while (cond) { __builtin_amdgcn_s_sleep(1); \
    if ((++_sp & 255u) == 0u) { if (xb_ld(&(bar)[XB_TMO])) break; if (_sp > XB_SPIN_CAP) { atomicAdd(&(bar)[XB_TMO], 1u); break; } } } } while (0)
struct XcdBarrier { unsigned* bar; unsigned x; volatile LAS unsigned* st; };
__device__ __forceinline__ XcdBarrier xcd_barrier_post(unsigned* bar, volatile LAS unsigned* st) {
    XcdBarrier b; b.bar = bar; b.x = xb_xcc_id(); b.st = st;
    if (threadIdx.x == 0) (void)xb_add(&bar[XB_XCNT(b.x)], 1u);
    return b;
}
__device__ __forceinline__ void xcd_barrier_complete(unsigned* bar, unsigned x, unsigned& nloc, unsigned& nx) {
    const unsigned G = gridDim.x * gridDim.y * gridDim.z;
    unsigned sum, cnt, mine, sp = 0u;
    for (;;) {
        sum = 0u; cnt = 0u; mine = 0u;
#pragma unroll
        for (unsigned j = 0; j < 16; ++j) { const unsigned c = xb_ld(&bar[XB_XCNT(j)]); sum += c; cnt += (c > 0u) ? 1u : 0u; mine = (j == x) ? c : mine; }
        if (sum == G) break;
        __builtin_amdgcn_s_sleep(1);
        if ((++sp & 255u) == 0u) { if (xb_ld(&bar[XB_TMO])) break; if (sp > XB_SPIN_CAP) { atomicAdd(&bar[XB_TMO], 1u); break; } }
    }
    nloc = mine > 0u ? mine : 1u; nx = cnt > 0u ? cnt : 1u;
}
__device__ __forceinline__ void xcd_barrier(const XcdBarrier& b, bool leader) {
    asm volatile("s_waitcnt vmcnt(0)" ::: "memory");
    __syncthreads();
    if (leader) {
        unsigned* bar = b.bar;
        __builtin_amdgcn_s_waitcnt(0);
        unsigned nloc = b.st[0], nx = b.st[1];
        if (nloc == 0u) { xcd_barrier_complete(bar, b.x, nloc, nx); b.st[0] = nloc; b.st[1] = nx; }
        const unsigned old = xb_add(&bar[XB_XSUB(b.x)], 1u);
        const unsigned gen = old / nloc;
        if (old + 1u == (gen + 1u) * nloc) {
            __builtin_amdgcn_fence(__ATOMIC_RELEASE, "agent");
            asm volatile("s_waitcnt vmcnt(0)" ::: "memory");
            const unsigned og = xb_add(&bar[XB_TOP], 1u);
            const unsigned tg = og / nx;
            if (og + 1u == (tg + 1u) * nx) xb_add(&bar[XB_TOPGEN], 1u);
            else XB_SPIN(xb_ld(&bar[XB_TOPGEN]) == tg, bar);
            __builtin_amdgcn_fence(__ATOMIC_ACQUIRE, "agent");
            xb_add(&bar[XB_XGEN(b.x)], 1u);
            asm volatile("s_waitcnt vmcnt(0)" ::: "memory");
        } else {
            XB_SPIN(xb_ld(&bar[XB_XGEN(b.x)]) == gen, bar);
            __builtin_amdgcn_fence(__ATOMIC_ACQUIRE, "agent");
            asm volatile("s_waitcnt vmcnt(0)" ::: "memory");
        }
    }
    __syncthreads();
}

namespace pg8 {
#define PG8_LAS __attribute__((address_space(3)))
constexpr int BM = 256, BK = 64, HALF = 128, HTB = HALF * BK * 2, STAGE_BYTES = 8 * HTB, NXCD = 8, WGM = 8;
__host__ __device__ __forceinline__ int lds_byte(int r, int c) { const int st = (r >> 4) * 2 + (c >> 5), rr = r & 15, cc = c & 31, ob = rr * 64 + cc * 2; return st * 1024 + (ob ^ (((ob >> 9) & 1) << 5)); }
__host__ __device__ __forceinline__ void stage_rc(int b, int& R, int& C) { const int st = b / 1024, sb = b % 1024, swz = sb ^ (((sb >> 9) & 1) << 5); R = (st >> 1) * 16 + swz / 64; C = (st & 1) * 32 + (swz % 64) / 2; }
__host__ __device__ __forceinline__ int perm32(int rho) { const int n = rho >> 4, i = rho & 15; return 8 * (i >> 2) + 4 * n + (i & 3); }

struct Unit { int pm, pn; const char* a; const char* b; int lb, nvalid; };
struct Gemm { int K, lda, ldb; };

struct TileMap {
    int nM, nN, nwg, G, c, maxi;
    __device__ __forceinline__ void init(int nM_, int nN_, int G_, int c_) { nM = nM_; nN = nN_; nwg = nM * nN; G = G_; c = c_; maxi = 0x7fffffff; }
    __device__ __forceinline__ bool map(int i, int& pm, int& pn) const { if (i >= maxi) return false; const long L = (long)i * G + c; if (L >= nwg) return false; mapL((int)L, pm, pn); return true; }
    __device__ __forceinline__ void mapL(int L, int& pm, int& pn) const {
        int wgid = L; { const int q = nwg / NXCD, r = nwg % NXCD, xcd = wgid % NXCD, off = wgid / NXCD; wgid = (xcd < r ? xcd * (q + 1) : r * (q + 1) + (xcd - r) * q) + off; }
        const int nig = WGM * nN, gid = wgid / nig, fm = gid * WGM, gsz = (nM - fm) < WGM ? (nM - fm) : WGM;
        pm = fm + ((wgid % nig) % gsz); pn = (wgid % nig) / gsz;
    }
};
struct SchedPlain {
    TileMap tm; const char* A; const char* Bt; size_t atile, btile;
    __device__ __forceinline__ bool next(int i, Unit& u) const { if (!tm.map(i, u.pm, u.pn)) return false; u.a = A + (size_t)u.pm * atile; u.b = Bt + (size_t)u.pn * btile; u.lb = 0; u.nvalid = 256; return true; }
    __device__ __forceinline__ void a_ready(const Unit&) const {}
    __device__ __forceinline__ void done(const Unit&) const {}
};
struct SchedPool {
    TileMap tm; const char* A; const char* Bt; size_t atile;
    __device__ __forceinline__ bool next(int i, Unit& u) const { if (!tm.map(i, u.pm, u.pn)) return false; u.a = A + (size_t)u.pm * atile + (size_t)u.pn * 512; u.b = Bt + (size_t)u.pn * 131072; u.lb = 0; u.nvalid = 256; return true; }
    __device__ __forceinline__ void a_ready(const Unit&) const {}
    __device__ __forceinline__ void done(const Unit&) const {}
};
struct SchedMoe {
    TileMap tm; const char* A; const char* Bt; size_t atile, btile, estride; const LAS int* pt; const int* toks;
    __device__ __forceinline__ bool next(int i, Unit& u) const { if (!tm.map(i, u.pm, u.pn)) return false; int e = 0;
#pragma unroll
        for (int k = 1; k < 8; ++k) e += (pt[k] <= u.pm) ? 1 : 0;
        const int rank0 = (u.pm - pt[e]) * 256; u.lb = e * NTOK + rank0; u.nvalid = pt[16 + e] - rank0;
        u.a = A + (size_t)u.pm * atile; u.b = Bt + (size_t)e * estride + (size_t)u.pn * btile; return true; }
    __device__ __forceinline__ const int* tok_src(const Unit& u) const { return toks + u.lb; }
    __device__ __forceinline__ void a_ready(const Unit&) const {}
    __device__ __forceinline__ void done(const Unit&) const {}
};

struct SchedMoeSplit {
    TileMap tm; const char* A; const char* Bt; size_t atile, btile, estride; const LAS int* pt; int first, nsplit;
    __device__ __forceinline__ bool next(int i, Unit& u) const { if (i > 0 || tm.c >= 4 * nsplit) return false; const int su = tm.c >> 2, q = tm.c & 3; tm.mapL(first + su, u.pm, u.pn); int e = 0;
#pragma unroll
        for (int k = 1; k < 8; ++k) e += (pt[k] <= u.pm) ? 1 : 0;
        u.lb = su * 4 + q; u.nvalid = 256; const size_t ko = (size_t)q * (DFFE / 4) * 2;
        u.a = A + (size_t)u.pm * atile + ko; u.b = Bt + (size_t)e * estride + (size_t)u.pn * btile + ko; return true; }
    __device__ __forceinline__ void a_ready(const Unit&) const {}
    __device__ __forceinline__ void done(const Unit&) const {}
};

struct EpiQKV {
    static constexpr bool PERM = true, AFTER_DRAIN = false;
    bf16_t* qkvb; const float* rope; const float* rinv;
    static __device__ __forceinline__ f32x4 rot(f32x4 c, f32x4 d) { f32x4 o; o[0] = c[0] * d[0] - c[1] * d[1]; o[1] = c[1] * d[0] + c[0] * d[1]; o[2] = c[2] * d[2] - c[3] * d[3]; o[3] = c[3] * d[2] + c[2] * d[3]; return o; }
    __device__ __forceinline__ void operator()(const f32x4 (&acc)[2][2][4][2], const Unit& u, int wr, int wc, int fr_, int fq) const {
        int fr = fr_; asm volatile("" : "+v"(fr));
        const int g = u.pn / 12, rem = u.pn - 12 * g, t = rem >> 2, cq = (rem & 3) * 256, dsh = 2 * g, Lg = SEQ >> dsh;
        bf16_t* buf = qkvb + (size_t)(g * 3 + t) * ((size_t)HTOK * DM);
        const int cb0 = cq + wc * 32 + 8 * fq, h0 = cb0 >> 6, p0 = cb0 & 63, i0 = p0 >> 1;
        const int rowb = u.pm * BM + wr * 64 + fr, s0 = rowb & 2047;
        f32x4 c0 = {1.f, 0.f, 1.f, 0.f}, c1 = c0, b0 = c0, b1 = c0, da = c0, db = c0;
        float rfs[2][4];
#pragma unroll
        for (int ai = 0; ai < 2; ++ai)
#pragma unroll
            for (int m = 0; m < 4; ++m) rfs[ai][m] = rinv[rowb + ai * HALF + m * 16];
        f32x4 ea = c0, eb = c0;
        if (t < 2) { const f32x4* cs = (const f32x4*)(rope + ((size_t)s0 * 32 + i0) * 2); b0 = cs[0]; b1 = cs[1]; const f32x4* dd = (const f32x4*)(rope + (size_t)SEQ * 64 + i0 * 2); da = dd[0]; db = dd[1]; ea = dd[16]; eb = dd[17]; }
        if (t == 2) {
#pragma unroll
            for (int ai = 0; ai < 2; ++ai)
#pragma unroll
                for (int m = 0; m < 4; ++m) { const int row = rowb + ai * HALF + m * 16, bl = row >> 11, s = row & 2047, r = s & ((1 << dsh) - 1), j = s >> dsh; const float rf = rfs[ai][m];
#pragma unroll
                    for (int bj = 0; bj < 2; ++bj) { const int seq = ((bl << dsh) + r) * NHEAD + h0 + 2 * bj; const f32x4 v0 = acc[ai][bj][m][0] * rf, v1 = acc[ai][bj][m][1] * rf;
                        u32x4 w; w.x = cvt_pk_bf16(v0[0], v0[1]); w.y = cvt_pk_bf16(v0[2], v0[3]); w.z = cvt_pk_bf16(v1[0], v1[1]); w.w = cvt_pk_bf16(v1[2], v1[3]);
                        *(u32x4*)(buf + ((size_t)seq * Lg + j) * HDIM + p0) = w; } }
        } else {
            const float qs = (t == 0) ? QSCALE : 1.0f;
#pragma unroll
            for (int ai = 0; ai < 2; ++ai) {
                if (ai == 1) { b0 = rot(b0, ea); b1 = rot(b1, eb); } c0 = b0; c1 = b1;
#pragma unroll
                for (int m = 0; m < 4; ++m) {
                    if (m > 0) { c0 = rot(c0, da); c1 = rot(c1, db); }
                    const int row = rowb + ai * HALF + m * 16, bl = row >> 11, s = row & 2047, r = s & ((1 << dsh) - 1), j = s >> dsh; const float rf = rfs[ai][m] * qs;
#pragma unroll
                    for (int bj = 0; bj < 2; ++bj) { const int seq = ((bl << dsh) + r) * NHEAD + h0 + 2 * bj; const f32x4 v0 = acc[ai][bj][m][0] * rf, v1 = acc[ai][bj][m][1] * rf;
                        f32x4 w0, w1; w0[0] = v0[0] * c0[0] - v0[1] * c0[1]; w0[1] = v0[1] * c0[0] + v0[0] * c0[1]; w0[2] = v0[2] * c0[2] - v0[3] * c0[3]; w0[3] = v0[3] * c0[2] + v0[2] * c0[3];
                        w1[0] = v1[0] * c1[0] - v1[1] * c1[1]; w1[1] = v1[1] * c1[0] + v1[0] * c1[1]; w1[2] = v1[2] * c1[2] - v1[3] * c1[3]; w1[3] = v1[3] * c1[2] + v1[2] * c1[3];
                        u32x4 w; w.x = cvt_pk_bf16(w0[0], w0[1]); w.y = cvt_pk_bf16(w0[2], w0[3]); w.z = cvt_pk_bf16(w1[0], w1[1]); w.w = cvt_pk_bf16(w1[2], w1[3]);
                        *(u32x4*)(buf + ((size_t)seq * Lg + j) * HDIM + p0) = w; } } }
        }
    }
};
template <bool SCALE, bool SSP> struct EpiResB {
    static constexpr bool PERM = true, AFTER_DRAIN = false;
    bf16_t* xb; const float* colscale; float* ssp;
    __device__ __forceinline__ void operator()(const f32x4 (&acc)[2][2][4][2], const Unit& u, int wr, int wc, int fr_, int fq) const {
        int fr = fr_; asm volatile("" : "+v"(fr));
        const int col0 = u.pn * BM + wc * 32 + 8 * fq;
        f32x4 sc[2][2];
        if (SCALE) {
#pragma unroll
            for (int bj = 0; bj < 2; ++bj) { sc[bj][0] = *(const f32x4*)(colscale + col0 + bj * HALF); sc[bj][1] = *(const f32x4*)(colscale + col0 + bj * HALF + 4); } }
#pragma unroll
        for (int ai = 0; ai < 2; ++ai) {
            u32x4 xin[4][2];
#pragma unroll
            for (int m = 0; m < 4; ++m)
#pragma unroll
                for (int bj = 0; bj < 2; ++bj) xin[m][bj] = *(const u32x4*)(xb + (size_t)(u.pm * BM + ai * HALF + wr * 64 + m * 16 + fr) * DM + col0 + bj * HALF);
#pragma unroll
            for (int m = 0; m < 4; ++m) { const int row = u.pm * BM + ai * HALF + wr * 64 + m * 16 + fr; const size_t off = (size_t)row * DM + col0; float ss = 0.f;
#pragma unroll
                for (int bj = 0; bj < 2; ++bj) { f32x4 v0 = acc[ai][bj][m][0], v1 = acc[ai][bj][m][1];
                    if (SCALE) { v0 = v0 * sc[bj][0]; v1 = v1 * sc[bj][1]; }
                    const u32x4 x = xin[m][bj];
                    v0[0] += __builtin_bit_cast(float, x.x << 16); v0[1] += __builtin_bit_cast(float, x.x & 0xffff0000u); v0[2] += __builtin_bit_cast(float, x.y << 16); v0[3] += __builtin_bit_cast(float, x.y & 0xffff0000u);
                    v1[0] += __builtin_bit_cast(float, x.z << 16); v1[1] += __builtin_bit_cast(float, x.z & 0xffff0000u); v1[2] += __builtin_bit_cast(float, x.w << 16); v1[3] += __builtin_bit_cast(float, x.w & 0xffff0000u);
                    u32x4 w; w.x = cvt_pk_bf16(v0[0], v0[1]); w.y = cvt_pk_bf16(v0[2], v0[3]); w.z = cvt_pk_bf16(v1[0], v1[1]); w.w = cvt_pk_bf16(v1[2], v1[3]);
                    *(u32x4*)(xb + off + bj * HALF) = w;
                    if (SSP) ss += (v0[0] * v0[0] + v0[1] * v0[1]) + (v0[2] * v0[2] + v0[3] * v0[3]) + (v1[0] * v1[0] + v1[1] * v1[1]) + (v1[2] * v1[2] + v1[3] * v1[3]); }
                if (SSP) { ss += __shfl_xor(ss, 16); ss += __shfl_xor(ss, 32); if (fq == 0) ssp[(size_t)(u.pn * 4 + wc) * NTOK + row] = ss; } }
        }
    }
};
template <int NORM> struct EpiGU {
    static constexpr bool PERM = true, AFTER_DRAIN = false;
    bf16_t* act; int ldact; const float* rv;
    __device__ __forceinline__ void operator()(const f32x4 (&acc)[2][2][4][2], const Unit& u, int wr, int wc, int fr_, int fq) const {
        int fr = fr_; asm volatile("" : "+v"(fr));
        const int col0 = u.pn * HALF + wc * 32 + 8 * fq;
#pragma unroll
        for (int ai = 0; ai < 2; ++ai) {
            float rr[4];
#pragma unroll
            for (int m = 0; m < 4; ++m) { const int lrow = ai * HALF + wr * 64 + m * 16 + fr; rr[m] = (NORM == 1) ? rv[u.pm * BM + lrow] : (NORM == 2) ? rv[u.lb + lrow] : 1.f; }
#pragma unroll
            for (int m = 0; m < 4; ++m) { const int row = u.pm * BM + ai * HALF + wr * 64 + m * 16 + fr; const float r = rr[m];
                f32x4 o[2];
#pragma unroll
                for (int n = 0; n < 2; ++n) { const f32x4 g4 = acc[ai][0][m][n] * r, u4 = acc[ai][1][m][n] * r, t4 = g4 * (-1.4426950408889634f);
                    f32x4 e4; e4[0] = __builtin_amdgcn_exp2f(t4[0]); e4[1] = __builtin_amdgcn_exp2f(t4[1]); e4[2] = __builtin_amdgcn_exp2f(t4[2]); e4[3] = __builtin_amdgcn_exp2f(t4[3]);
                    const f32x4 d4 = e4 + 1.0f; f32x4 i4; i4[0] = __builtin_amdgcn_rcpf(d4[0]); i4[1] = __builtin_amdgcn_rcpf(d4[1]); i4[2] = __builtin_amdgcn_rcpf(d4[2]); i4[3] = __builtin_amdgcn_rcpf(d4[3]);
                    o[n] = (g4 * u4) * i4; }
                u32x4 w; w.x = cvt_pk_bf16(o[0][0], o[0][1]); w.y = cvt_pk_bf16(o[0][2], o[0][3]); w.z = cvt_pk_bf16(o[1][0], o[1][1]); w.w = cvt_pk_bf16(o[1][2], o[1][3]);
                *(u32x4*)(act + (size_t)row * ldact + col0) = w; } }
    }
};
struct EpiMoeDown {
    static constexpr bool PERM = true, AFTER_DRAIN = false;
    bf16_t* y; const float* gate; const int* ydst;
    __device__ __forceinline__ void operator()(const f32x4 (&acc)[2][2][4][2], const Unit& u, int wr, int wc, int fr_, int fq) const {
        int fr = fr_; asm volatile("" : "+v"(fr));
        const int col0 = u.pn * BM + wc * 32 + 8 * fq;
        float gg[2][4]; int dd[2][4];
#pragma unroll
        for (int ai = 0; ai < 2; ++ai)
#pragma unroll
            for (int m = 0; m < 4; ++m) { const int lrow = ai * HALF + wr * 64 + m * 16 + fr; const bool ok = lrow < u.nvalid; gg[ai][m] = ok ? gate[u.lb + lrow] : 0.f; dd[ai][m] = ok ? ydst[u.lb + lrow] : -1; }
#pragma unroll
        for (int ai = 0; ai < 2; ++ai)
#pragma unroll
            for (int m = 0; m < 4; ++m) { const float gt = gg[ai][m]; if (dd[ai][m] >= 0) {
#pragma unroll
                for (int bj = 0; bj < 2; ++bj) { const f32x4 v0 = acc[ai][bj][m][0] * gt, v1 = acc[ai][bj][m][1] * gt;
                    u32x4 w; w.x = cvt_pk_bf16(v0[0], v0[1]); w.y = cvt_pk_bf16(v0[2], v0[3]); w.z = cvt_pk_bf16(v1[0], v1[1]); w.w = cvt_pk_bf16(v1[2], v1[3]);
                    *(u32x4*)(y + (size_t)dd[ai][m] * DM + col0 + bj * HALF) = w; } } }
    }
};


struct EpiPart {
    static constexpr bool PERM = true, AFTER_DRAIN = false;
    float* part;
    __device__ __forceinline__ void operator()(const f32x4 (&acc)[2][2][4][2], const Unit& u, int wr, int wc, int fr_, int fq) const {
        int fr = fr_; asm volatile("" : "+v"(fr));
        float* base = part + (size_t)u.lb * 65536 + wc * 32 + 8 * fq;
#pragma unroll
        for (int ai = 0; ai < 2; ++ai)
#pragma unroll
            for (int m = 0; m < 4; ++m) { float* rp = base + (size_t)(ai * HALF + wr * 64 + m * 16 + fr) * 256;
#pragma unroll
                for (int bj = 0; bj < 2; ++bj) { *(f32x4*)(rp + bj * HALF) = acc[ai][bj][m][0]; *(f32x4*)(rp + bj * HALF + 4) = acc[ai][bj][m][1]; } }
    }
};

template <class Epi, class Sched, bool ALIGN_EPI = false, bool SP2 = false, bool GA = false>
__device__ __forceinline__ void gemm_phase(PG8_LAS unsigned char* lds, const Gemm g, const Sched& S, const Epi& E, int tid_in) {
    int tid_ = tid_in; asm volatile("" : "+v"(tid_));
    const int tid = tid_, wid = __builtin_amdgcn_readfirstlane(tid >> 6), lane = tid & 63, wr = wid >> 2, wc = wid & 3, fr = lane & 15, fq = lane >> 4;
    const int K = g.K, nt = K / BK, lda = g.lda, ldb = g.ldb;
    unsigned voffA[2], voffB[2];
#pragma unroll
    for (int i = 0; i < 2; ++i) { int R, C; stage_rc(tid * 16 + i * 8192, R, C); const int Rb = Epi::PERM ? ((R & ~31) + perm32(R & 31)) : R;
        voffA[i] = (unsigned)(R * lda + C) * 2u; voffB[i] = (unsigned)(Rb * ldb + C) * 2u; }
    unsigned gA0[2] = {0u, 0u}, gA1[2] = {0u, 0u}; PG8_LAS int* const tokL = (PG8_LAS int*)(lds + TOK_OFF); (void)gA0; (void)gA1; (void)tokL;
    static_assert(SP2 || !GA, "gathered A needs the SP2 loop");
    const size_t kstep = (size_t)(BK * 2);
    const size_t hstepA = (size_t)HALF * lda * 2, hstepB = (size_t)HALF * ldb * 2;
    const unsigned ldsw = (unsigned)wid * 1024u;
    const int aoff = lds_byte(wr * 64 + fr, fq * 8), boff = lds_byte(wc * 32 + fr, fq * 8);
#define PG8_SA(b, h) (((b) * 2 + (h)) * HTB)
#define PG8_SB(b, h) ((4 + (b) * 2 + (h)) * HTB)
#define PG8_STAGE(bufoff, gbase, voff) do { _Pragma("unroll") for (int _i = 0; _i < 2; ++_i) \
        __builtin_amdgcn_global_load_lds((const unsigned*)((const char*)(gbase) + (voff)[_i]), (PG8_LAS unsigned*)(lds + (bufoff) + ldsw + _i * 8192), 16, 0, 0); } while (0)
#define PG8_STAGE_A(bufoff, gbase, h) do { if constexpr (GA) { if ((h) == 0) PG8_STAGE(bufoff, gbase, gA0); else PG8_STAGE(bufoff, gbase, gA1); } \
        else { if ((h) == 0) PG8_STAGE(bufoff, gbase, voffA); else PG8_STAGE(bufoff, (gbase) + hstepA, voffA); } } while (0)
#define PG8_GOFFS(buf, un) do { _Pragma("unroll") for (int _i = 0; _i < 2; ++_i) { int R_, C_; stage_rc(tid * 16 + _i * 8192, R_, C_); \
        int t0_, t1_; asm volatile("ds_read_b32 %0, %2\n\tds_read_b32 %1, %2 offset:512\n\ts_waitcnt lgkmcnt(0)" : "=&v"(t0_), "=&v"(t1_) : "v"((unsigned)(size_t)(tokL + (buf) * 256 + R_)) : "memory");     \
        t0_ = (R_ < (un).nvalid) ? t0_ : 0; t1_ = (128 + R_ < (un).nvalid) ? t1_ : 0; \
        gA0[_i] = (unsigned)(t0_ * lda + C_) * 2u; gA1[_i] = (unsigned)(t1_ * lda + C_) * 2u; } } while (0)
#define PG8_TOKDMA(buf, un) __builtin_amdgcn_global_load_lds((const unsigned*)(S.tok_src(un) + lane * 4), (PG8_LAS unsigned*)(tokL + (buf) * 256), 16, 0, 0)
#define PG8_LDA(dst, b, h) do { _Pragma("unroll") for (int m = 0; m < 4; ++m) _Pragma("unroll") for (int k = 0; k < 2; ++k) dst[m][k] = *(const PG8_LAS bf16x8*)(lds + PG8_SA(b, h) + aoff + m * 2048 + k * 1024); } while (0)
#define PG8_LDB(dst, b, h) do { _Pragma("unroll") for (int n = 0; n < 2; ++n) _Pragma("unroll") for (int k = 0; k < 2; ++k) dst[n][k] = *(const PG8_LAS bf16x8*)(lds + PG8_SB(b, h) + boff + n * 2048 + k * 1024); } while (0)
#define PG8_MMA(ai, bj, At, Bt) do { __builtin_amdgcn_s_setprio(1); _Pragma("unroll") for (int m = 0; m < 4; ++m) _Pragma("unroll") for (int n = 0; n < 2; ++n) _Pragma("unroll") for (int k = 0; k < 2; ++k) \
        acc[ai][bj][m][n] = __builtin_amdgcn_mfma_f32_16x16x32_bf16(Bt[n][k], At[m][k], acc[ai][bj][m][n], 0, 0, 0); __builtin_amdgcn_s_setprio(0); } while (0)
#define PG8_WAIT_V(n) asm volatile("s_waitcnt vmcnt(" #n ")" ::: "memory")
#define PG8_WAIT_L(n) asm volatile("s_waitcnt lgkmcnt(" #n ")" ::: "memory")
#define PG8_BAR __builtin_amdgcn_s_barrier()
#define PG8_SCHED __builtin_amdgcn_sched_barrier(0)
    Unit cur, nxt; int ui = 0;
    if (!S.next(0, cur)) return;
    f32x4 acc[2][2][4][2];
#pragma unroll
    for (int a = 0; a < 2; ++a)
#pragma unroll
        for (int b = 0; b < 2; ++b)
#pragma unroll
            for (int m = 0; m < 4; ++m)
#pragma unroll
                for (int n = 0; n < 2; ++n) acc[a][b][m][n] = (f32x4){0.f, 0.f, 0.f, 0.f};
    bf16x8 At[4][2], B0[2][2], B1[2][2];
    const char* cA = cur.a; const char* cB = cur.b;
    S.a_ready(cur);
    if constexpr (GA) { if (wid == 0) PG8_TOKDMA(0, cur); PG8_WAIT_V(0); PG8_BAR; PG8_GOFFS(0, cur); }
    if constexpr (SP2) {
        PG8_STAGE(PG8_SB(0, 0), cB, voffB); PG8_STAGE(PG8_SB(0, 1), cB + hstepB, voffB); PG8_STAGE_A(PG8_SA(0, 0), cA, 0); PG8_STAGE_A(PG8_SA(0, 1), cA, 1);
        if (wr == 1) PG8_BAR;
        PG8_WAIT_V(2); PG8_BAR;
        PG8_STAGE(PG8_SB(1, 0), cB + kstep, voffB); PG8_STAGE_A(PG8_SA(1, 0), cA + kstep, 0); PG8_STAGE(PG8_SB(1, 1), cB + hstepB + kstep, voffB);
        PG8_WAIT_V(6); PG8_BAR;
    } else {
        PG8_STAGE(PG8_SB(0, 0), cB, voffB); PG8_STAGE(PG8_SA(0, 0), cA, voffA); PG8_STAGE(PG8_SB(0, 1), cB + hstepB, voffB); PG8_STAGE(PG8_SA(0, 1), cA + hstepA, voffA);
        if (wr == 1) PG8_BAR;
        PG8_WAIT_V(4); PG8_BAR;
        PG8_STAGE(PG8_SB(1, 0), cB + kstep, voffB); PG8_STAGE(PG8_SA(1, 0), cA + kstep, voffA); PG8_STAGE(PG8_SB(1, 1), cB + hstepB + kstep, voffB);
        PG8_WAIT_V(6); PG8_BAR;
    }
    for (;;) {
        const bool has_next = S.next(ui + 1, nxt);
        if constexpr (GA) { if (has_next && wid == 0) PG8_TOKDMA((ui + 1) & 1, nxt); }
        const char* nA = has_next ? nxt.a : cA; const char* nB = has_next ? nxt.b : cB;
#pragma nounroll
        for (int t = 0; t < nt; t += 2) {
            const bool last = (t == nt - 2);
            const char* a1 = cA + (size_t)(t + 1) * kstep;
            const char* a2 = last ? nA : cA + (size_t)(t + 2) * kstep; const char* b2 = last ? nB : cB + (size_t)(t + 2) * kstep;
            const char* a3 = a2 + kstep; const char* b3 = b2 + kstep;
            if (last && has_next) S.a_ready(nxt);
            if constexpr (SP2) {
            PG8_LDB(B0, 0, 0); PG8_LDB(B1, 0, 1); PG8_SCHED; PG8_LDA(At, 0, 0); PG8_STAGE_A(PG8_SA(1, 1), a1, 1);
            if constexpr (GA) { if (last && has_next) PG8_GOFFS((ui + 1) & 1, nxt); }
            PG8_WAIT_V(8); PG8_WAIT_L(0); PG8_BAR; PG8_MMA(0, 0, At, B0); PG8_MMA(0, 1, At, B1); PG8_BAR; PG8_SCHED;
            PG8_LDA(At, 0, 1); PG8_STAGE(PG8_SB(0, 0), b2, voffB); PG8_STAGE(PG8_SB(0, 1), b2 + hstepB, voffB); PG8_STAGE_A(PG8_SA(0, 0), a2, 0);
            PG8_WAIT_V(8); PG8_WAIT_L(0); PG8_BAR; PG8_MMA(1, 0, At, B0); PG8_MMA(1, 1, At, B1); PG8_BAR; PG8_SCHED;
            PG8_LDB(B0, 1, 0); PG8_LDB(B1, 1, 1); PG8_SCHED; PG8_LDA(At, 1, 0); PG8_STAGE_A(PG8_SA(0, 1), a2, 1);
            PG8_WAIT_V(8); PG8_WAIT_L(0); PG8_BAR; PG8_MMA(0, 0, At, B0); PG8_MMA(0, 1, At, B1); PG8_BAR; PG8_SCHED;
            PG8_LDA(At, 1, 1); PG8_STAGE(PG8_SB(1, 0), b3, voffB); PG8_STAGE(PG8_SB(1, 1), b3 + hstepB, voffB); PG8_STAGE_A(PG8_SA(1, 0), a3, 0);
            PG8_WAIT_V(8); PG8_WAIT_L(0); PG8_BAR; PG8_MMA(1, 0, At, B0); PG8_MMA(1, 1, At, B1); PG8_BAR; PG8_SCHED;
            } else {
            PG8_LDB(B0, 0, 0); PG8_SCHED; PG8_LDA(At, 0, 0); PG8_STAGE(PG8_SA(1, 1), a1 + hstepA, voffA);
            PG8_WAIT_L(8); PG8_BAR; PG8_WAIT_L(0); PG8_MMA(0, 0, At, B0); PG8_BAR; PG8_SCHED;
            PG8_LDB(B1, 0, 1); PG8_STAGE(PG8_SB(0, 0), b2, voffB);
            PG8_BAR; PG8_WAIT_L(0); PG8_MMA(0, 1, At, B1); PG8_BAR;
            PG8_LDA(At, 0, 1); PG8_STAGE(PG8_SA(0, 0), a2, voffA);
            PG8_BAR; PG8_WAIT_L(0); PG8_MMA(1, 0, At, B0); PG8_BAR; PG8_SCHED;
            PG8_STAGE(PG8_SB(0, 1), b2 + hstepB, voffB);
            PG8_WAIT_V(6); PG8_BAR; PG8_MMA(1, 1, At, B1); PG8_BAR;
            PG8_LDB(B0, 1, 0); PG8_SCHED; PG8_LDA(At, 1, 0); PG8_STAGE(PG8_SA(0, 1), a2 + hstepA, voffA);
            PG8_WAIT_L(8); PG8_BAR; PG8_WAIT_L(0); PG8_MMA(0, 0, At, B0); PG8_BAR; PG8_SCHED;
            PG8_LDB(B1, 1, 1); PG8_STAGE(PG8_SB(1, 0), b3, voffB);
            PG8_BAR; PG8_WAIT_L(0); PG8_MMA(0, 1, At, B1); PG8_BAR;
            PG8_LDA(At, 1, 1); PG8_STAGE(PG8_SA(1, 0), a3, voffA);
            PG8_BAR; PG8_WAIT_L(0); PG8_MMA(1, 0, At, B0); PG8_BAR; PG8_SCHED;
            PG8_STAGE(PG8_SB(1, 1), b3 + hstepB, voffB);
            PG8_WAIT_V(6); PG8_BAR; PG8_MMA(1, 1, At, B1); PG8_BAR;
            }
        }
        if constexpr (ALIGN_EPI) { if (wr == 0) PG8_BAR; }
        if constexpr (!Epi::AFTER_DRAIN) { E(acc, cur, wr, wc, fr, fq); S.done(cur); }
        if (!has_next) break;
#pragma unroll
        for (int a = 0; a < 2; ++a)
#pragma unroll
            for (int b = 0; b < 2; ++b)
#pragma unroll
                for (int m = 0; m < 4; ++m)
#pragma unroll
                    for (int n = 0; n < 2; ++n) acc[a][b][m][n] = (f32x4){0.f, 0.f, 0.f, 0.f};
        cur = nxt; cA = nA; cB = nB; ++ui;
        if constexpr (ALIGN_EPI) { if (wr == 1) PG8_BAR; }
    }
    PG8_WAIT_V(0);
    if constexpr (!ALIGN_EPI) { if (wr == 0) PG8_BAR; }
    PG8_BAR;
    if constexpr (Epi::AFTER_DRAIN) { E.fused(acc, cur, wr, wc, fr, fq, lds, wid, lane); S.done(cur); }
#undef PG8_SA
#undef PG8_SB
#undef PG8_STAGE
#undef PG8_STAGE_A
#undef PG8_GOFFS
#undef PG8_TOKDMA
#undef PG8_LDA
#undef PG8_LDB
#undef PG8_MMA
#undef PG8_WAIT_V
#undef PG8_WAIT_L
#undef PG8_BAR
#undef PG8_SCHED
}
}

namespace att {
__device__ __forceinline__ int koff(int row, int ch) { return row * 128 + ((ch ^ (((row >> 1) & 3) << 1)) << 4); }
constexpr int LDS_K = 0, LDS_V = 32768, OST_OFF = RING_BYTES + 1024;
__device__ __forceinline__ s16x4 vtr(const LAS unsigned char* p) { return __builtin_bit_cast(s16x4, __builtin_amdgcn_ds_read_tr16_b64_v4i16((LAS s16x4*)p)); }

constexpr int NU = 5120;
__device__ __forceinline__ void decode_unit(int u, int& g, int& seq, int& jt) {
    g = u >> 11; const int ug = u & 2047;
    if (g == 0) { seq = ug >> 4; jt = (ug + seq) & 15; } else if (g == 1) { seq = ug >> 2; jt = (ug + seq) & 3; } else { seq = 2 * ug; jt = 0; }
}
__device__ __forceinline__ void load_tile(u32x4 (&pf)[8], const bf16_t* qkvb, int u, int tid) {
    int g, seq, jt; decode_unit(u, g, seq, jt); const int Lg = SEQ >> (2 * g);
    const bf16_t* kb = qkvb + (size_t)(g * 3 + 1) * ((size_t)HTOK * DM) + ((size_t)seq * Lg + (size_t)jt * 128 - 128) * HDIM;
    const bf16_t* vb = kb + (size_t)HTOK * DM;
    const size_t pair = (g == 2) ? (size_t)(Lg + 128) * HDIM : 0;
#pragma unroll
    for (int i = 0; i < 4; ++i) { const int q = tid + 512 * i; const bool lo = q < 1024, ok = (jt > 0) || !lo || (g == 2); const size_t o = (size_t)q * 8 + ((lo && g == 2) ? pair : 0);
        pf[i] = ok ? *(const u32x4*)(kb + o) : (u32x4){0u, 0u, 0u, 0u}; pf[4 + i] = ok ? *(const u32x4*)(vb + o) : (u32x4){0u, 0u, 0u, 0u}; }
}
__device__ __forceinline__ void load_q(bf16x8& q0, bf16x8& q1, bf16x8& q2, bf16x8& q3, const bf16_t* qkvb, int u, int wid, int lane) {
    int g, seq, jt; decode_unit(u, g, seq, jt); const int Lg = SEQ >> (2 * g); const bf16_t* qbase = qkvb + (size_t)(g * 3) * ((size_t)HTOK * DM) + 8 * (lane >> 4);
    const bool pr = (g == 2), lo = wid < 4;
    const int sF = pr ? (lo ? seq : seq + 1) : seq, rF = pr ? (lo ? wid + 4 : wid) * 16 : jt * 128 + wid * 16, sH = pr ? (lo ? seq + 1 : seq) : sF, rH = pr ? (wid & 3) * 16 : rF;
    const bf16_t* qf = qbase + ((size_t)sF * Lg + rF + (lane & 15)) * HDIM; const bf16_t* qh = qbase + ((size_t)sH * Lg + rH + (lane & 15)) * HDIM;
    q0 = *(const bf16x8*)qf; q1 = *(const bf16x8*)(qf + 32); q2 = *(const bf16x8*)qh; q3 = *(const bf16x8*)(qh + 32);
}
__device__ __forceinline__ void store_tile(const u32x4 (&pf)[8], LAS unsigned char* lds, int tid) {
#pragma unroll
    for (int i = 0; i < 4; ++i) { const int q = tid + 512 * i, row = q >> 3, ch = q & 7; *(LAS u32x4*)(lds + LDS_K + koff(row, ch)) = pf[i]; *(LAS u32x4*)(lds + LDS_V + koff(row, ch)) = pf[4 + i]; }
}
__device__ __forceinline__ float max3(float a, float b, float c) { return __builtin_fmaxf(__builtin_fmaxf(a, b), c); }
__device__ __forceinline__ float xrow_max(float v) {
    auto r = __builtin_amdgcn_permlane16_swap(__float_as_uint(v), __float_as_uint(v), false, false); v = __builtin_fmaxf(__uint_as_float(r[0]), __uint_as_float(r[1]));
    auto q = __builtin_amdgcn_permlane32_swap(__float_as_uint(v), __float_as_uint(v), false, false); return __builtin_fmaxf(__uint_as_float(q[0]), __uint_as_float(q[1])); }
__device__ __forceinline__ float xrow_sum(float v) {
    auto r = __builtin_amdgcn_permlane16_swap(__float_as_uint(v), __float_as_uint(v), false, false); v = __uint_as_float(r[0]) + __uint_as_float(r[1]);
    auto q = __builtin_amdgcn_permlane32_swap(__float_as_uint(v), __float_as_uint(v), false, false); return __uint_as_float(q[0]) + __uint_as_float(q[1]); }
template <int TS, bool MERGE>
__device__ __forceinline__ void compute_unit(const LAS unsigned char* ldsb, LAS unsigned char* ost, LAS float* ostl, const bf16x8 q0, const bf16x8 q1, bf16_t* opart, float* lse, bf16_t* hbout, int g, int seq, int jt, int wid, int rshift, int lane) {
    const int dsh = 2 * g, Lg = SEQ >> dsh; const LAS unsigned char* lds = ldsb + rshift;
    const int fr = lane & 15, grp = lane >> 4;
    const int h = seq & 15, br = seq >> 4, bl = br >> dsh, r = br & ((1 << dsh) - 1);
    const int j = jt * 128 + wid * 16 + fr;
    (void)Lg;
    const int t0 = (jt == 0) ? (8 - wid) : 0;
    const int s2 = ((fr >> 1) & 3) << 1;
    const LAS unsigned char* kb0 = lds + LDS_K + (wid * 16 + fr) * 128 + ((grp ^ s2) << 4);
    const LAS unsigned char* kb1 = lds + LDS_K + (wid * 16 + fr) * 128 + (((4 + grp) ^ s2) << 4);
    f32x4 S[9];
#pragma unroll
    for (int t = 0; t < TS; ++t) S[t] = (f32x4){-1e30f, -1e30f, -1e30f, -1e30f};
    constexpr int TM = (TS == 0) ? 5 : 9;
    {   bf16x8 kf0[9], kf1[9];
#pragma unroll
        for (int t = TS; t < TM; ++t) { kf0[t] = *(const LAS bf16x8*)(kb0 + t * 2048); kf1[t] = *(const LAS bf16x8*)(kb1 + t * 2048); }
        __builtin_amdgcn_sched_barrier(0);
#pragma unroll
        for (int t = TS; t < TM; ++t) S[t] = __builtin_amdgcn_mfma_f32_16x16x32_bf16(kf0[t], q0, (f32x4){0.f, 0.f, 0.f, 0.f}, 0, 0, 0);
#pragma unroll
        for (int t = TS; t < TM; ++t) S[t] = __builtin_amdgcn_mfma_f32_16x16x32_bf16(kf1[t], q1, S[t], 0, 0, 0);
        __builtin_amdgcn_sched_barrier(0);
#pragma unroll
        for (int t = TM; t < 9; ++t) { kf0[t] = *(const LAS bf16x8*)(kb0 + t * 2048); kf1[t] = *(const LAS bf16x8*)(kb1 + t * 2048); }
        __builtin_amdgcn_sched_barrier(0);
#pragma unroll
        for (int t = TM; t < 9; ++t) S[t] = __builtin_amdgcn_mfma_f32_16x16x32_bf16(kf0[t], q0, (f32x4){0.f, 0.f, 0.f, 0.f}, 0, 0, 0);
#pragma unroll
        for (int t = TM; t < 9; ++t) S[t] = __builtin_amdgcn_mfma_f32_16x16x32_bf16(kf1[t], q1, S[t], 0, 0, 0);
    }
    __builtin_amdgcn_sched_barrier(0);
    const int iq = fr >> 2, ip = fr & 3, sv2 = ((iq >> 1) | ((grp & 1) << 1)) << 1;
    const LAS unsigned char* vrow = lds + LDS_V + (wid * 16 + 4 * grp + iq) * 128 + 8 * (ip & 1);
    s16x4 vl[5][4], vh[4][4];
#pragma unroll
    for (int dt = 0; dt < 4; ++dt) { const LAS unsigned char* vb = vrow + (((2 * dt + (ip >> 1)) ^ sv2) << 4);
#pragma unroll
        for (int c = TS / 2; c < 3; ++c) { vl[c][dt] = vtr(vb + c * 4096); vh[c][dt] = vtr(vb + c * 4096 + 2048); } }
    __builtin_amdgcn_sched_barrier(0);
    u32x4 mo0[2], mo1[2]; float ml0[2], ml1[2];
    if (MERGE) {
#pragma unroll
        for (int k = 0; k < 2; ++k) { const size_t trow = (size_t)bl * SEQ + ((size_t)(jt * 128 + wid * 16 + (lane >> 3) + 8 * k) << dsh) + r;
            mo0[k] = *(const u32x4*)(opart + trow * DM + h * HDIM + (lane & 7) * 8); mo1[k] = *(const u32x4*)(opart + (size_t)HTOK * DM + trow * DM + h * HDIM + (lane & 7) * 8);
            ml0[k] = lse[trow * NHEAD + h]; ml1[k] = lse[(size_t)HTOK * NHEAD + trow * NHEAD + h]; } }
    const float NEG = -1e30f;
    if (t0 > 0) {
#pragma unroll
        for (int t = TS; t < 8; ++t) { const bool tv = t >= t0; S[t][0] = tv ? S[t][0] : NEG; S[t][1] = tv ? S[t][1] : NEG; S[t][2] = tv ? S[t][2] : NEG; S[t][3] = tv ? S[t][3] : NEG; } }
#pragma unroll
    for (int e = 0; e < 4; ++e) { if (TS == 0) S[0][e] = (4 * grp + e >= fr) ? S[0][e] : NEG; S[8][e] = (4 * grp + e <= fr) ? S[8][e] : NEG; }
    float mx = max3(S[0][0], S[0][1], S[0][2]);
    mx = max3(mx, S[0][3], S[8][3]);
#pragma unroll
    for (int t = 1; t < 8; ++t) { mx = max3(mx, S[t][0], S[t][1]); mx = max3(mx, S[t][2], S[t][3]); }
    mx = max3(mx, S[8][0], S[8][1]); mx = __builtin_fmaxf(mx, S[8][2]);
    mx = xrow_max(mx);
    f32x4 lsv = {0.f, 0.f, 0.f, 0.f};
#pragma unroll
    for (int t = TS; t < 9; ++t) { const f32x4 d = S[t] - mx;
        S[t][0] = __builtin_amdgcn_exp2f(d[0]); S[t][1] = __builtin_amdgcn_exp2f(d[1]); S[t][2] = __builtin_amdgcn_exp2f(d[2]); S[t][3] = __builtin_amdgcn_exp2f(d[3]);
        lsv = lsv + S[t]; }
    float ls = (lsv[0] + lsv[1]) + (lsv[2] + lsv[3]);
    ls = xrow_sum(ls);
    bf16x8 pf[5];
#pragma unroll
    for (int c = TS / 2; c < 5; ++c) { u32x4 pw; pw.x = cvt_pk_bf16(S[2 * c][0], S[2 * c][1]); pw.y = cvt_pk_bf16(S[2 * c][2], S[2 * c][3]);
        if (c < 4) { pw.z = cvt_pk_bf16(S[2 * c + 1][0], S[2 * c + 1][1]); pw.w = cvt_pk_bf16(S[2 * c + 1][2], S[2 * c + 1][3]); } else { pw.z = 0u; pw.w = 0u; }
        pf[c] = __builtin_bit_cast(bf16x8, pw); }
    __builtin_amdgcn_sched_barrier(0);
#pragma unroll
    for (int dt = 0; dt < 4; ++dt) { const LAS unsigned char* vb = vrow + (((2 * dt + (ip >> 1)) ^ sv2) << 4);
        vl[3][dt] = vtr(vb + 3 * 4096); vh[3][dt] = vtr(vb + 3 * 4096 + 2048); vl[4][dt] = vtr(vb + 4 * 4096); }
    __builtin_amdgcn_sched_barrier(0);
    f32x4 O[4];
#pragma unroll
    for (int dt = 0; dt < 4; ++dt) O[dt] = (f32x4){0.f, 0.f, 0.f, 0.f};
#pragma unroll
    for (int c = TS / 2; c < 5; ++c)
#pragma unroll
        for (int dt = 0; dt < 4; ++dt) { const s16x4 lo = vl[c][dt]; s16x4 hi = (s16x4){0, 0, 0, 0}; if (c < 4) hi = vh[c][dt];
            const bf16x8 vf = (bf16x8){lo[0], lo[1], lo[2], lo[3], hi[0], hi[1], hi[2], hi[3]};
            O[dt] = __builtin_amdgcn_mfma_f32_16x16x32_bf16(vf, pf[c], O[dt], 0, 0, 0); }
    __builtin_amdgcn_sched_barrier(0);
    const float inv = __builtin_amdgcn_rcpf(ls);
    const size_t tokrow = (size_t)bl * SEQ + ((size_t)j << dsh) + r;
#pragma unroll
    for (int dt = 0; dt < 4; ++dt) { u32x2 w; w.x = cvt_pk_bf16(O[dt][0] * inv, O[dt][1] * inv); w.y = cvt_pk_bf16(O[dt][2] * inv, O[dt][3] * inv); *(LAS u32x2*)(ost + fr * 128 + dt * 32 + grp * 8) = w; }
    if (MERGE) { if (grp == 0) ostl[fr] = mx + __builtin_amdgcn_logf(ls); }
    LDS_WAIT();
#pragma unroll
    for (int k = 0; k < 2; ++k) { const int qq = (lane >> 3) + 8 * k; const u32x4 w = *(const LAS u32x4*)(ost + qq * 128 + (lane & 7) * 16);
        const size_t trow = (size_t)bl * SEQ + ((size_t)(jt * 128 + wid * 16 + qq) << dsh) + r;
        if (MERGE) { const float l2 = ostl[qq], l0 = ml0[k], l1 = ml1[k], mm = max3(l0, l1, l2);
            float w0 = __builtin_amdgcn_exp2f(l0 - mm), w1 = __builtin_amdgcn_exp2f(l1 - mm), w2 = __builtin_amdgcn_exp2f(l2 - mm); const float wi = __builtin_amdgcn_rcpf(w0 + w1 + w2); w0 *= wi; w1 *= wi; w2 *= wi;
            u32x4 o;
#pragma unroll
            for (int e = 0; e < 4; ++e) { const float lo = w0 * bf2f((unsigned short)(mo0[k][e] & 0xffffu)) + w1 * bf2f((unsigned short)(mo1[k][e] & 0xffffu)) + w2 * bf2f((unsigned short)(w[e] & 0xffffu));
                const float hi = w0 * bf2f((unsigned short)(mo0[k][e] >> 16)) + w1 * bf2f((unsigned short)(mo1[k][e] >> 16)) + w2 * bf2f((unsigned short)(w[e] >> 16)); o[e] = cvt_pk_bf16(lo, hi); }
            *(u32x4*)(hbout + trow * DM + h * HDIM + (lane & 7) * 8) = o; }
        else *(u32x4*)(opart + (size_t)g * ((size_t)HTOK * DM) + trow * DM + h * HDIM + (lane & 7) * 8) = w; }
    if (!MERGE) { if (grp == 0) lse[(size_t)g * ((size_t)HTOK * NHEAD) + tokrow * NHEAD + h] = mx + __builtin_amdgcn_logf(ls); }
}
template <bool G2> __device__ __forceinline__ void attn_range(LAS unsigned char* lds, const bf16_t* qkvb, bf16_t* opart, float* lse, bf16_t* hbout, int G, int ubeg, int uend, int tid, int wid, int lane) {
    u32x4 pA[8]; bf16x8 q0, q1, q2, q3, a0, a1, a2, a3;
    LAS unsigned char* ost = lds + OST_OFF + wid * 2048; LAS float* ostl = (LAS float*)(lds + OST_OFF + 16384 + wid * 64);
    int u = ubeg, buf = 0;
    if (u < uend) { load_tile(pA, qkvb, u, tid); load_q(q0, q1, q2, q3, qkvb, u, wid, lane); store_tile(pA, lds, tid); }
    __syncthreads();
    while (u < uend) {
        const bool more = u + G < uend;
        if (more) { load_tile(pA, qkvb, u + G, tid); load_q(a0, a1, a2, a3, qkvb, u + G, wid, lane); }
        { int g_, s_, jt_; decode_unit(u, g_, s_, jt_); const LAS unsigned char* lb_ = lds + buf * 65536;
          if (!G2) compute_unit<0, false>(lb_, ost, ostl, q0, q1, opart, lse, hbout, g_, s_, jt_, wid, 0, lane);
          else { const bool lo_ = wid < 4;
              compute_unit<0, true>(lb_, ost, ostl, q0, q1, opart, lse, hbout, 2, lo_ ? s_ : s_ + 1, 0, lo_ ? wid + 4 : wid, lo_ ? 0 : -16384, lane);
              compute_unit<4, true>(lb_, ost, ostl, q2, q3, opart, lse, hbout, 2, lo_ ? s_ + 1 : s_, 0, wid & 3, lo_ ? -16384 : 0, lane); } }
        if (more) { store_tile(pA, lds + (buf ^ 1) * 65536, tid); q0 = a0; q1 = a1; q2 = a2; q3 = a3; }
        asm volatile("s_waitcnt lgkmcnt(0)" ::: "memory"); __builtin_amdgcn_s_barrier(); asm volatile("" ::: "memory");
        buf ^= 1; u += G;
    }
}
__device__ __forceinline__ void attn_phase(LAS unsigned char* lds, const bf16_t* qkvb, bf16_t* opart, float* lse, bf16_t* hbout, const XcdBarrier& bar, int G, int c, int tid_in) {
    int tid_ = tid_in; asm volatile("" : "+v"(tid_));
    const int tid = tid_, wid = __builtin_amdgcn_readfirstlane(tid >> 6), lane = tid & 63;
    attn_range<false>(lds, qkvb, opart, lse, hbout, G, c, 4096, tid, wid, lane);
    xcd_barrier(bar, tid == 0);
    attn_range<true>(lds, qkvb, opart, lse, hbout, G, 4096 + c, NU, tid, wid, lane);
}
}
struct Args { const float* in[15]; float* out; unsigned char* ws; int ph_lo, ph_hi, li, pad; };
struct Frame {
    LAS unsigned char* lds; unsigned* ctl; int tid, lane, wave, vcu, G;
    const float *x_in, *mix_norm, *ffn_norm, *w_qkv, *w_o, *pool_w, *pool_scale, *dg, *du, *dd, *router, *mg, *mu, *md, *final_norm;
    float* xo; unsigned char* ws;
};
typedef const __attribute__((address_space(4))) Args* KArgs;
__device__ __forceinline__ void build_frame(Frame& F, LAS unsigned char* lds, int wv) {
    KArgs A = (KArgs)__builtin_amdgcn_kernarg_segment_ptr(); asm volatile("" : "+s"(A));
    F.lds = lds; F.lane = lane_id(); F.wave = wv; F.tid = wv * 64 + F.lane;
    F.G = gridDim.x; { const int bx = blockIdx.x; F.vcu = (F.G % 8 == 0) ? (bx % 8) * (F.G / 8) + bx / 8 : bx; }
    F.ws = A->ws; F.ctl = (unsigned*)(A->ws + WS_CTL); F.xo = A->out;
    F.x_in = A->in[0]; F.mix_norm = A->in[1]; F.ffn_norm = A->in[2]; F.w_qkv = A->in[3]; F.w_o = A->in[4]; F.pool_w = A->in[5]; F.pool_scale = A->in[6];
    F.dg = A->in[7]; F.du = A->in[8]; F.dd = A->in[9]; F.router = A->in[10]; F.mg = A->in[11]; F.mu = A->in[12]; F.md = A->in[13]; F.final_norm = A->in[14];
}
struct ConvItem { const float* W; bf16_t* WT; const float* gain; int K, N, mode, item; };
__device__ __forceinline__ void conv_load(f32x4 (&v)[8], const ConvItem& c, int lane) {
    const int nblk = c.N / 32, kb = c.item / nblk, nb = c.item - kb * nblk;
    const float* p = c.W + (size_t)(64 * kb + (lane >> 3)) * c.N + 32 * nb + 4 * (lane & 7);
#pragma unroll
    for (int i = 0; i < 8; ++i) v[i] = *(const f32x4*)(p + (size_t)(8 * i) * c.N);
}
__device__ __forceinline__ void conv_store(const f32x4 (&v)[8], const ConvItem& c, LAS float* scr, int lane) {
    const int nblk = c.N / 32, kb = c.item / nblk, nb = c.item - kb * nblk, k0 = 64 * kb, n0 = 32 * nb;
    int rbase = n0, rstride = 1;
    if (c.mode == 1) rbase = (n0 >> 7) * 256 + (n0 & 127);
    else if (c.mode == 2) rbase = (n0 >> 7) * 256 + 128 + (n0 & 127);
    else if (c.mode == 3) { const int t = (n0 % 3072) >> 10; if (t < 2) { rbase = (n0 & ~63) + ((n0 >> 5) & 1); rstride = 2; } }
#pragma unroll
    for (int i = 0; i < 8; ++i)
#pragma unroll
        for (int q = 0; q < 4; ++q) scr[(4 * (lane & 7) + q) * 65 + 8 * i + (lane >> 3)] = v[i][q];
    LDS_WAIT(); asm volatile("" ::: "memory");
    const int cc = lane & 7;
    f32x4 g0 = {1.f, 1.f, 1.f, 1.f}, g1 = g0; if (c.gain) { g0 = *(const f32x4*)(c.gain + k0 + 8 * cc); g1 = *(const f32x4*)(c.gain + k0 + 8 * cc + 4); }
#pragma unroll
    for (int j = 0; j < 4; ++j) { const int n = (lane >> 3) + 8 * j; const LAS float* s = scr + n * 65 + 8 * cc;
        u32x4 o; o.x = pk2(s[0] * g0[0], s[1] * g0[1]); o.y = pk2(s[2] * g0[2], s[3] * g0[3]); o.z = pk2(s[4] * g1[0], s[5] * g1[1]); o.w = pk2(s[6] * g1[2], s[7] * g1[3]);
        *(u32x4*)(c.WT + (size_t)(rbase + rstride * n) * c.K + k0 + 8 * cc) = o; }
    LDS_WAIT(); asm volatile("" ::: "memory");
}
template <class Resolve> __device__ __forceinline__ void convert_run(Frame& F, int first, int total, int pidx, int P, const Resolve& R) {
    LAS float* scr = (LAS float*)(F.lds + F.wave * 16384);
    const int NGW = P * 8; int it = first + pidx * 8 + F.wave;
    f32x4 v[8], vn[8], vm[8]; ConvItem cur, nx, nn;
    if (it < total) { R(it, cur); conv_load(v, cur, F.lane); }
    if (it + NGW < total) { R(it + NGW, nx); conv_load(vn, nx, F.lane); }
    while (it < total) {
        const int n2 = it + 2 * NGW;
        if (n2 < total) { R(n2, nn); conv_load(vm, nn, F.lane); }
        conv_store(v, cur, scr, F.lane);
#pragma unroll
        for (int i = 0; i < 8; ++i) { v[i] = vn[i]; vn[i] = vm[i]; }
        cur = nx; nx = nn;
        it += NGW;
    }
}
__device__ __forceinline__ void convert_moe(Frame& F, int f, int part = 0, int pidx = -1, int P = 0) {
    const size_t EW = (size_t)DM * DFFE;
    constexpr int per = (DM / 64) * (DFFE / 32);
    const float* mg = F.mg; const float* mu = F.mu; const float* md = F.md; unsigned char* ws = F.ws; const float* gn = F.ffn_norm + (size_t)(2 * f + 1) * DM;
    if (pidx < 0) { pidx = F.vcu; P = F.G; }
    convert_run(F, part == 2 ? 2 * 8 * per : 0, part == 1 ? 2 * 8 * per : 3 * 8 * per, pidx, P, [=](int it, ConvItem& c) { const int which = it / (8 * per), rr = it - which * 8 * per, e = rr / per; c.item = rr - e * per;
        if (which == 0)      { c.W = mg + ((size_t)f * 8 + e) * EW; c.K = DM; c.N = DFFE; c.WT = (bf16_t*)(ws + WS_WMGU) + (size_t)e * 2 * EW; c.mode = 1; c.gain = gn; }
        else if (which == 1) { c.W = mu + ((size_t)f * 8 + e) * EW; c.K = DM; c.N = DFFE; c.WT = (bf16_t*)(ws + WS_WMGU) + (size_t)e * 2 * EW; c.mode = 2; c.gain = gn; }
        else                 { c.W = md + ((size_t)f * 8 + e) * EW; c.K = DFFE; c.N = DM; c.WT = (bf16_t*)(ws + WS_WMD) + (size_t)e * EW; c.mode = 0; c.gain = nullptr; } });
}
__device__ __forceinline__ void convert_static(Frame& F) {
    constexpr int P_QKV = (DM / 64) * (NQKV / 32), P_O = (DM / 64) * (DM / 32), P_POOL = 4 * 8, P_DG = (DM / 64) * (DFF / 32), P_DD = (DFF / 64) * (DM / 32);
    constexpr int T0 = 2 * P_QKV, T1 = T0 + 2 * P_O, T2 = T1 + 8 * P_POOL, T3 = T2 + 2 * P_DG, T4 = T3 + 2 * P_DG, T5 = T4 + 2 * P_DD;
    const float* w_qkv = F.w_qkv; const float* w_o = F.w_o; const float* pool_w = F.pool_w; const float* dg = F.dg; const float* du = F.du; const float* dd = F.dd; unsigned char* ws = F.ws; const float* mixn = F.mix_norm; const float* ffnn = F.ffn_norm;
    convert_run(F, 0, T5, F.vcu, F.G, [=](int it, ConvItem& c) {
        if (it < T0) { const int l = it / P_QKV; c.item = it - l * P_QKV; c.W = w_qkv + (size_t)l * DM * NQKV; c.K = DM; c.N = NQKV; c.WT = (bf16_t*)(ws + WS_WQKV) + (size_t)l * NQKV * DM; c.mode = 3; c.gain = mixn + (size_t)(2 * l) * DM; }
        else if (it < T1) { const int q = it - T0, l = q / P_O; c.item = q - l * P_O; c.W = w_o + (size_t)l * DM * DM; c.K = DM; c.N = DM; c.WT = (bf16_t*)(ws + WS_WO) + (size_t)l * DM * DM; c.mode = 0; c.gain = nullptr; }
        else if (it < T2) { const int q = it - T1, l = q / P_POOL; c.item = q - l * P_POOL; c.W = pool_w + (size_t)l * 65536; c.K = 256; c.N = 256; c.WT = (bf16_t*)(ws + WS_WPOOL) + (size_t)l * 65536; c.mode = 0; c.gain = nullptr; }
        else if (it < T3) { const int q = it - T2, l = q / P_DG; c.item = q - l * P_DG; c.W = dg + (size_t)l * DM * DFF; c.K = DM; c.N = DFF; c.WT = (bf16_t*)(ws + WS_WDGU) + (size_t)l * 2 * DFF * DM; c.mode = 1; c.gain = ffnn + (size_t)(2 * l) * DM; }
        else if (it < T4) { const int q = it - T3, l = q / P_DG; c.item = q - l * P_DG; c.W = du + (size_t)l * DM * DFF; c.K = DM; c.N = DFF; c.WT = (bf16_t*)(ws + WS_WDGU) + (size_t)l * 2 * DFF * DM; c.mode = 2; c.gain = ffnn + (size_t)(2 * l) * DM; }
        else { const int q = it - T4, l = q / P_DD; c.item = q - l * P_DD; c.W = dd + (size_t)l * DFF * DM; c.K = DFF; c.N = DM; c.WT = (bf16_t*)(ws + WS_WDD) + (size_t)l * DM * DFF; c.mode = 0; c.gain = nullptr; } });
}
__device__ __forceinline__ void rope_table(Frame& F) {
    float* tab = (float*)(F.ws + WS_ROPE);
    for (int i = F.vcu * 512 + F.tid; i < SEQ * 32; i += F.G * 512) { const int s = i >> 5, k = i & 31;
        const float inv = powf(10000.0f, -(float)(2 * k) / 64.0f), ang = (float)s * inv; tab[2 * i] = cosf(ang); tab[2 * i + 1] = sinf(ang); }
    if (F.vcu == 0 && F.tid < 64) { const int k = F.tid & 31; const float inv = powf(10000.0f, -(float)(2 * k) / 64.0f), ang = (F.tid < 32 ? 16.0f : 128.0f) * inv; tab[SEQ * 64 + 2 * F.tid] = cosf(ang); tab[SEQ * 64 + 2 * F.tid + 1] = sinf(ang); }
}
__device__ __forceinline__ float ss16(const float* ssp, size_t row) { float s = 0.f;
#pragma unroll
    for (int q = 0; q < 16; ++q) s += ssp[(size_t)q * NTOK + row];
    return s; }
__device__ __forceinline__ void rinv_pass(Frame& F) { const float* ssp = (const float*)(F.ws + WS_SSP); float* ri = (float*)(F.ws + WS_RINV);
    for (int i = F.vcu * 512 + F.tid; i < NTOK; i += F.G * 512) ri[i] = 1.0f / sqrtf(ss16(ssp, i) * (1.0f / DM) + RMS_EPS); }
__device__ __forceinline__ f32x4 bf4(u32x2 a) { return (f32x4){__builtin_bit_cast(float, a.x << 16), __builtin_bit_cast(float, a.x & 0xffff0000u), __builtin_bit_cast(float, a.y << 16), __builtin_bit_cast(float, a.y & 0xffff0000u)}; }
__device__ __forceinline__ void cast_rows(Frame& F) {
    const int gw = F.vcu * 8 + F.wave, NGW = F.G * 8, lane = F.lane; bf16_t* xb = (bf16_t*)(F.ws + WS_XB); float* rq = (float*)(F.ws + WS_RINV) + NTOK;
    for (int m0 = gw; m0 < NTOK; m0 += 2 * NGW) { const int m1 = (m0 + NGW < NTOK) ? m0 + NGW : m0;
        f32x4 va[4], vb[4];
#pragma unroll
        for (int j = 0; j < 4; ++j) { va[j] = ((const f32x4*)(F.x_in + (size_t)m0 * DM))[lane + 64 * j]; vb[j] = ((const f32x4*)(F.x_in + (size_t)m1 * DM))[lane + 64 * j]; }
#pragma unroll
        for (int q = 0; q < 2; ++q) { const int m = q ? m1 : m0; u32x2* o8 = (u32x2*)(xb + (size_t)m * DM) + lane; float s = 0.f;
#pragma unroll
            for (int j = 0; j < 4; ++j) { const f32x4 v = q ? vb[j] : va[j]; s += (v[0] * v[0] + v[1] * v[1]) + (v[2] * v[2] + v[3] * v[3]); u32x2 w; w.x = pk2(v[0], v[1]); w.y = pk2(v[2], v[3]); o8[64 * j] = w; }
            s = wave_sum(s); if (lane == 0) rq[m] = 1.0f / sqrtf(s * (1.0f / DM) + RMS_EPS); }
    }
}
__device__ __forceinline__ void merge_half(Frame& F, int hb) {
    const bf16_t* op = (const bf16_t*)(F.ws + WS_OPART); const float* lse = (const float*)(F.ws + WS_LSE); bf16_t* out = (bf16_t*)(F.ws + WS_HB) + (size_t)hb * HTOK * DM;
    const int stride = F.G * 512;
    for (int it0 = F.vcu * 512 + F.tid; it0 < HTOK * 128; it0 += 2 * stride) {
        u32x4 a[2], b[2], c[2]; float l0[2], l1[2], l2[2]; size_t off[2];
#pragma unroll
        for (int q = 0; q < 2; ++q) { const int it = (it0 + q * stride < HTOK * 128) ? it0 + q * stride : it0; const int row = it >> 7, ci = it & 127, h = ci >> 3; off[q] = (size_t)row * DM + ci * 8;
            l0[q] = lse[(size_t)row * 16 + h]; l1[q] = lse[(size_t)HTOK * 16 + (size_t)row * 16 + h]; l2[q] = lse[(size_t)2 * HTOK * 16 + (size_t)row * 16 + h];
            a[q] = *(const u32x4*)(op + off[q]); b[q] = *(const u32x4*)(op + (size_t)HTOK * DM + off[q]); c[q] = *(const u32x4*)(op + (size_t)2 * HTOK * DM + off[q]); }
#pragma unroll
        for (int q = 0; q < 2; ++q) {
            const float mx = fmaxf(l0[q], fmaxf(l1[q], l2[q])); float w0 = __builtin_amdgcn_exp2f(l0[q] - mx), w1 = __builtin_amdgcn_exp2f(l1[q] - mx), w2 = __builtin_amdgcn_exp2f(l2[q] - mx);
            const float inv = 1.0f / (w0 + w1 + w2); w0 *= inv; w1 *= inv; w2 *= inv;
            u32x4 o;
#pragma unroll
            for (int k = 0; k < 4; ++k) { const float lo = w0 * bf2f((unsigned short)(a[q][k] & 0xffffu)) + w1 * bf2f((unsigned short)(b[q][k] & 0xffffu)) + w2 * bf2f((unsigned short)(c[q][k] & 0xffffu));
                const float hi = w0 * bf2f((unsigned short)(a[q][k] >> 16)) + w1 * bf2f((unsigned short)(b[q][k] >> 16)) + w2 * bf2f((unsigned short)(c[q][k] >> 16)); o[k] = pk2(lo, hi); }
            *(u32x4*)(out + off[q]) = o; }
    }
}
__device__ __forceinline__ void pool_prep(Frame& F, const float* gain) {
    const bf16_t* x = (const bf16_t*)(F.ws + WS_XB); const float* ssp = (const float*)(F.ws + WS_SSP2); bf16_t* pa = (bf16_t*)(F.ws + WS_HB);
    const int gw = F.vcu * 8 + F.wave, NGW = F.G * 8, lane = F.lane;
    for (int item = gw; item < 16 * 32 * 4; item += NGW) {
        const int b = item >> 7, rem = item & 127, ch = rem >> 2, g = rem & 3, P = 2 << g, t0 = ch * 64, c = 256 * g + 4 * lane;
        const size_t row0 = (size_t)b * SEQ;
        float rA = 0.f, rB = 0.f;
        { const int t = t0 - 16 + lane; if (t >= 0) rA = 1.0f / sqrtf(ss16(ssp, row0 + t) * (1.0f / DM) + RMS_EPS);
          if (lane < 16) rB = 1.0f / sqrtf(ss16(ssp, row0 + t0 + 48 + lane) * (1.0f / DM) + RMS_EPS); }
#define POOL_R(t) (((t) - (t0 - 16)) < 64 ? __builtin_bit_cast(float, __builtin_amdgcn_readlane(__builtin_bit_cast(int, rA), (t) - (t0 - 16))) : __builtin_bit_cast(float, __builtin_amdgcn_readlane(__builtin_bit_cast(int, rB), (t) - (t0 + 48))))
#define POOL_X(t) bf4(*(const u32x2*)(x + (row0 + (t)) * DM + c))
        const f32x4 gm = *(const f32x4*)(gain + c);
        f32x4 S = (f32x4){0.f, 0.f, 0.f, 0.f};
        {   u32x2 xw[16];
#pragma unroll
            for (int i = 0; i < 16; ++i) { const int t = t0 - 16 + i; xw[i] = *(const u32x2*)(x + (row0 + (t > 0 ? t : 0)) * DM + c); }
#pragma unroll
            for (int i = 0; i < 16; ++i) { const int t = t0 - 16 + i; if (t >= t0 - P && t >= 0) { const float r = POOL_R(t); S = S + bf4(xw[i]) * r * gm; } } }
        u32x2 xc[8], xo[8], yc[8], yo[8];
#define POOL_LD(XC, XO, TB) do { _Pragma("unroll") for (int i = 0; i < 8; ++i) { XC[i] = *(const u32x2*)(x + (row0 + (TB) + i) * DM + c); const int tp = (TB) + i - P; XO[i] = *(const u32x2*)(x + (row0 + (tp >= 0 ? tp : 0)) * DM + c); } } while (0)
#define POOL_DO(XC, XO, TB) do { _Pragma("unroll") for (int i = 0; i < 8; ++i) { const int t = (TB) + i; \
                const float r = POOL_R(t); const f32x4 cur = bf4(XC[i]) * r * gm; S = S + cur; \
                if (t - P >= 0) { const float r2 = POOL_R(t - P); S = S - bf4(XO[i]) * r2 * gm; } \
                const float ic = 1.0f / (float)(t + 1 < P ? t + 1 : P); const f32x4 o = S * ic - cur; \
                u32x2 w; w.x = pk2(o[0], o[1]); w.y = pk2(o[2], o[3]); *(u32x2*)(pa + (row0 + t) * DM + c) = w; } } while (0)
        POOL_LD(xc, xo, t0);
        for (int tb = t0; tb < t0 + 64; tb += 16) {
            POOL_LD(yc, yo, tb + 8); POOL_DO(xc, xo, tb);
            if (tb + 16 < t0 + 64) POOL_LD(xc, xo, tb + 16);
            POOL_DO(yc, yo, tb + 8);
        }
#undef POOL_LD
#undef POOL_DO
#undef POOL_R
#undef POOL_X
    }
}
__device__ __forceinline__ void router_pass(Frame& F, int lp, const float* gain, const float* wr) {
    const bf16_t* x = (const bf16_t*)(F.ws + WS_XB); unsigned char* rt = F.ws + WS_RT; (void)lp;
    LAS int* sel = (LAS int*)F.lds;
    const int lane = F.lane;
    float wg[4][4][8];
#pragma unroll
    for (int j = 0; j < 4; ++j)
#pragma unroll
        for (int q = 0; q < 4; ++q) { const int c = 4 * lane + 256 * j + q; const float g = gain[c]; const f32x4 a = *(const f32x4*)(wr + (size_t)c * 8), b = *(const f32x4*)(wr + (size_t)c * 8 + 4);
            wg[j][q][0] = g * a[0]; wg[j][q][1] = g * a[1]; wg[j][q][2] = g * a[2]; wg[j][q][3] = g * a[3]; wg[j][q][4] = g * b[0]; wg[j][q][5] = g * b[1]; wg[j][q][6] = g * b[2]; wg[j][q][7] = g * b[3]; }
    for (int chunk = F.vcu; chunk < NTOK / 128; chunk += F.G) { const int tok0 = chunk * 128;
        u32x2 xn[4];
#pragma unroll
        for (int j = 0; j < 4; ++j) xn[j] = ((const u32x2*)(x + (size_t)(tok0 + F.wave * 16) * DM))[lane + 64 * j];
        for (int tk = 0; tk < 16; ++tk) { const int tl = F.wave * 16 + tk, token = tok0 + tl;
            u32x2 xr[4]; float s = 0.f, lg[8];
#pragma unroll
            for (int j = 0; j < 4; ++j) xr[j] = xn[j];
            if (tk < 15) {
#pragma unroll
                for (int j = 0; j < 4; ++j) xn[j] = ((const u32x2*)(x + (size_t)(token + 1) * DM))[lane + 64 * j]; }
#pragma unroll
            for (int e = 0; e < 8; ++e) lg[e] = 0.f;
#pragma unroll
            for (int j = 0; j < 4; ++j) { const f32x4 v = bf4(xr[j]); s += (v[0] * v[0] + v[1] * v[1]) + (v[2] * v[2] + v[3] * v[3]);
#pragma unroll
                for (int q = 0; q < 4; ++q)
#pragma unroll
                    for (int e = 0; e < 8; ++e) lg[e] += v[q] * wg[j][q][e]; }
            s = wave_sum(s); const float r = 1.0f / sqrtf(s * (1.0f / DM) + RMS_EPS);
#pragma unroll
            for (int e = 0; e < 8; ++e) lg[e] = wave_sum(lg[e]) * r;
            int i0 = 0; float v0 = lg[0];
#pragma unroll
            for (int e = 1; e < 8; ++e) if (lg[e] > v0) { v0 = lg[e]; i0 = e; }
            int i1 = -1; float v1 = -3.0e38f;
#pragma unroll
            for (int e = 0; e < 8; ++e) if (e != i0 && lg[e] > v1) { v1 = lg[e]; i1 = e; }
            const float g0 = 1.0f / (1.0f + expf(v1 - v0)), g1 = 1.0f - g0;
            if (lane == 0) { sel[2 * tl] = i0; sel[2 * tl + 1] = i1; ((f32x2*)(rt + RT_GATE))[token] = (f32x2){g0, g1}; ((float*)(rt + RT_R))[token] = r; ((int*)(rt + RT_E))[2 * token] = i0; ((int*)(rt + RT_E))[2 * token + 1] = i1; }
        }
        __syncthreads();
        LAS int* wcnt = (LAS int*)(F.lds + 1024);
        int rk = 0, ex = 0;
        if (F.wave < 4) { const int a = F.wave * 64 + lane; ex = sel[a]; int cmine = 0;
#pragma unroll
            for (int ee = 0; ee < 8; ++ee) { const unsigned long long m = __ballot(ex == ee); if (ex == ee) rk = __popcll(m & ((1ull << lane) - 1ull)); if (lane == ee) cmine = __popcll(m); }
            if (lane < 8) wcnt[F.wave * 8 + lane] = cmine; }
        __syncthreads();
        if (F.wave < 4) { int base = 0; for (int w2 = 0; w2 < F.wave; ++w2) base += wcnt[w2 * 8 + ex]; ((int*)(rt + RT_RANK))[2 * tok0 + F.wave * 64 + lane] = base + rk; }
        else if (F.tid < 264) { const int e8 = F.tid - 256; ((int*)(rt + RT_CNTB))[chunk * 8 + e8] = (wcnt[e8] + wcnt[8 + e8]) + (wcnt[16 + e8] + wcnt[24 + e8]); }
        __syncthreads();
    }
}
__device__ __forceinline__ void router_lists(Frame& F, int lp) {
    unsigned char* rt = F.ws + WS_RT; const int* cntb = (const int*)(rt + RT_CNTB);
    int* ltok = (int*)(F.ws + WS_LISTS); float* lgate = (float*)(F.ws + WS_LISTS + MiB); float* lr = (float*)(F.ws + WS_LISTS + 2 * MiB); int* ldst = (int*)(F.ws + WS_LISTS + 3 * MiB);
    LAS int* base = (LAS int*)F.lds;
    for (int chunk = F.vcu; chunk < NTOK / 128; chunk += F.G) { const int tok0 = chunk * 128;
        LAS int* part = (LAS int*)(F.lds + 64);
        if (F.tid < 256) { const int c2 = F.tid; const u32x4 n0 = *(const u32x4*)(cntb + c2 * 8), n1 = *(const u32x4*)(cntb + c2 * 8 + 4);
#pragma unroll
            for (int e = 0; e < 8; ++e) { const int n = (int)(e < 4 ? n0[e] : n1[e - 4]); const float bs = wave_sum((float)((c2 < chunk) ? n : 0)), ts = wave_sum((float)n);
                if (F.lane == 0) { part[F.wave * 16 + e] = (int)bs; part[F.wave * 16 + 8 + e] = (int)ts; } } }
        __syncthreads();
        if (F.tid < 8) { const int e = F.tid; base[e] = (part[e] + part[16 + e]) + (part[32 + e] + part[48 + e]);
            if (chunk == 0) F.ctl[CW_CNT + 64 * lp + e] = (unsigned)((part[8 + e] + part[24 + e]) + (part[40 + e] + part[56 + e])); }
        __syncthreads();
        if (F.tid < 256) { const int a = F.tid, token = tok0 + (a >> 1), k = a & 1; const int e = ((const int*)(rt + RT_E))[2 * token + k], rank = base[e] + ((const int*)(rt + RT_RANK))[2 * tok0 + a], li = e * NTOK + rank;
            ((int*)(rt + RT_RANK))[2 * tok0 + a] = rank; ltok[li] = token; lgate[li] = ((const float*)(rt + RT_GATE))[2 * token + k]; lr[li] = ((const float*)(rt + RT_R))[token]; ldst[li] = 2 * token + k; }
        __syncthreads();
    }
}
__device__ __forceinline__ int expert_tiles_lds(Frame& F, int lp) {
    const unsigned* cnt = F.ctl + CW_CNT + 64 * lp; int acc = 0; LAS int* pt = (LAS int*)(F.lds + MISC_OFF) + 16;
    const int mine = (int)cnt[F.lane & 7];
#pragma unroll
    for (int e = 0; e < 8; ++e) { const int c = __builtin_amdgcn_readlane(mine, e); if (F.tid == 0) { pt[e] = acc; pt[16 + e] = c; } acc += (c + 255) >> 8; }
    if (F.tid == 0) pt[8] = acc;
    __syncthreads();
    return acc;
}
__device__ __forceinline__ void moe_fixup(Frame& F, const pg8::TileMap& tm, int first, int nsplit) {
    const float* part = (const float*)(F.ws + WS_PART); const float* lgate = (const float*)(F.ws + WS_LISTS + MiB); const int* ldst = (const int*)(F.ws + WS_LISTS + 3 * MiB); bf16_t* y = (bf16_t*)(F.ws + WS_Y);
    const LAS int* pt = (const LAS int*)(F.lds + MISC_OFF) + 16;
    const int gw = F.vcu * 8 + F.wave, NGW = F.G * 8, lane = F.lane;
    for (int it = gw; it < nsplit * 256; it += NGW) { const int su = it >> 8, lrow = it & 255; int pm, pn; tm.mapL(first + su, pm, pn); int e = 0;
#pragma unroll
        for (int k = 1; k < 8; ++k) e += (pt[k] <= pm) ? 1 : 0;
        const int rank0 = (pm - pt[e]) * 256, nvalid = pt[16 + e] - rank0; if (lrow >= nvalid) continue;
        const int li = e * NTOK + rank0 + lrow; const float gt = lgate[li]; const int dst = ldst[li];
        const float* p = part + (size_t)(su * 4) * 65536 + (size_t)lrow * 256 + 4 * lane;
        const f32x4 s = ((*(const f32x4*)p + *(const f32x4*)(p + 65536)) + (*(const f32x4*)(p + 2 * 65536) + *(const f32x4*)(p + 3 * 65536))) * gt;
        u32x2 w; w.x = pk2(s[0], s[1]); w.y = pk2(s[2], s[3]); *(u32x2*)(y + (size_t)dst * DM + pn * 256 + 4 * lane) = w; }
}
__device__ __forceinline__ void combine_pass(Frame& F, int lp, const float* gain, bool last) {
    bf16_t* xb = (bf16_t*)(F.ws + WS_XB); const bf16_t* y = (const bf16_t*)(F.ws + WS_Y); float* rq = (float*)(F.ws + WS_RINV) + NTOK;
    const int gw = F.vcu * 8 + F.wave, NGW = F.G * 8, lane = F.lane; (void)lp;
    for (int t0 = gw; t0 < NTOK; t0 += 2 * NGW) {
        const int t1 = (t0 + NGW < NTOK) ? t0 + NGW : t0;
        u32x2 xa[4], ya[4], za[4], xc[4], yc[4], zc[4];
#pragma unroll
        for (int j = 0; j < 4; ++j) { xa[j] = ((const u32x2*)(xb + (size_t)t0 * DM))[lane + 64 * j]; ya[j] = ((const u32x2*)(y + (size_t)(2 * t0) * DM))[lane + 64 * j]; za[j] = ((const u32x2*)(y + (size_t)(2 * t0 + 1) * DM))[lane + 64 * j];
            xc[j] = ((const u32x2*)(xb + (size_t)t1 * DM))[lane + 64 * j]; yc[j] = ((const u32x2*)(y + (size_t)(2 * t1) * DM))[lane + 64 * j]; zc[j] = ((const u32x2*)(y + (size_t)(2 * t1 + 1) * DM))[lane + 64 * j]; }
#pragma unroll
        for (int q = 0; q < 2; ++q) { const int token = q ? t1 : t0; f32x4 v[4]; float s = 0.f;
#pragma unroll
            for (int j = 0; j < 4; ++j) { const f32x4 t = q ? (bf4(xc[j]) + bf4(yc[j]) + bf4(zc[j])) : (bf4(xa[j]) + bf4(ya[j]) + bf4(za[j])); v[j] = t; s += (t[0] * t[0] + t[1] * t[1]) + (t[2] * t[2] + t[3] * t[3]); }
            const float r = 1.0f / sqrtf(wave_sum(s) * (1.0f / DM) + RMS_EPS);
            if (last) { f32x4* orow = (f32x4*)(F.xo + (size_t)token * DM) + lane;
#pragma unroll
                for (int j = 0; j < 4; ++j) orow[64 * j] = v[j] * r * ((const f32x4*)gain)[lane + 64 * j]; }
            else { u32x2* xr = (u32x2*)(xb + (size_t)token * DM) + lane;
#pragma unroll
                for (int j = 0; j < 4; ++j) { u32x2 w; w.x = pk2(v[j][0], v[j][1]); w.y = pk2(v[j][2], v[j][3]); xr[64 * j] = w; }
                if (lane == 0) rq[token] = r; } }
    }
}

constexpr int NPH = 19;
enum { PH_PRE = 0, PH_QKV0, PH_ATT0, PH_MRG0, PH_QKV1, PH_ATT1, PH_MRG1, PH_WO, PH_RINV, PH_DGU, PH_DDOWN, PH_PPREP, PH_PGEMM, PH_ROUTE, PH_RLIST, PH_MGU, PH_MDOWN, PH_MFIX, PH_COMB };

__global__ void __launch_bounds__(512, 2) fwd(Args args) {
    extern __shared__ __attribute__((aligned(16))) unsigned char lds_raw[];
    LAS unsigned char* const lds = (LAS unsigned char*)lds_raw;
    const int wv = __builtin_amdgcn_readfirstlane((int)threadIdx.x >> 6);
    for (int u = threadIdx.x; u < (LDS_BYTES - RING_BYTES) / 4; u += 512) ((LAS unsigned*)(lds + RING_BYTES))[u] = 0u;
    __syncthreads();
    XcdBarrier bar = xcd_barrier_post((unsigned*)(args.ws + WS_CTL) + CW_BAR + args.li * XCD_BAR_WORDS, (volatile LAS unsigned*)(lds + MISC_OFF) + 8);
    const int lo = args.ph_lo, hi = args.ph_hi;
#define FRAME() Frame F; build_frame(F, lds, wv); unsigned char* ws = F.ws; bf16_t* XB = (bf16_t*)(ws + WS_XB); (void)XB

#if PROBE
    if (blockIdx.x == 0 && threadIdx.x == 0) { ((unsigned long long*)(args.ws + WS_SNAP))[0] = __builtin_amdgcn_s_memrealtime(); }
    if (blockIdx.x == PROBE_BLK && threadIdx.x == 0) { for (int k = 64; k < 72; ++k) ((unsigned long long*)(args.ws + WS_SNAP))[k] = 0ull; }
#endif
    for (int lp = 0; lp < 2; ++lp) {
#define PHID(k) (lp * NPH + (k))
#ifndef PHMASK
#define PHMASK 0xfffff
#endif
#define IN(k) (((PHMASK >> ((k) >= PH_QKV1 && (k) <= PH_MRG1 ? (k) - 3 : (k))) & 1) && lo <= PHID(k) && PHID(k) < hi)
#if PROBE
#define SEAM(k) do { if (PHID(k) + 1 < hi) xcd_barrier(bar, wv == 0 && lane_id() == 0); if (blockIdx.x == 0 && threadIdx.x == 0) ((unsigned long long*)(args.ws + WS_SNAP))[PHID(k) + 1] = __builtin_amdgcn_s_memrealtime(); } while (0)
#else
#define SEAM(k) do { if (PHID(k) + 1 < hi) xcd_barrier(bar, wv == 0 && lane_id() == 0); } while (0)
#endif
        if (lp == 0 && IN(PH_PRE)) { FRAME(); convert_static(F); convert_moe(F, 0); rope_table(F); cast_rows(F); SEAM(PH_PRE); }
        for (int hb = 0; hb < 2; ++hb) {
            if (IN(PH_QKV0 + 3 * hb)) { FRAME();
                pg8::SchedPlain S; S.tm.init(HTOK / 256, NQKV / 256, F.G, (int)blockIdx.x); S.A = (const char*)(XB + (size_t)hb * HTOK * DM); S.Bt = (const char*)(ws + WS_WQKV) + (size_t)lp * NQKV * DM * 2; S.atile = 256 * DM * 2; S.btile = 256 * DM * 2;
                pg8::EpiQKV E{(bf16_t*)(ws + WS_QKVB), (const float*)(ws + WS_ROPE), (const float*)(ws + WS_RINV) + NTOK + (size_t)hb * HTOK};
                pg8::gemm_phase<pg8::EpiQKV, pg8::SchedPlain, true, true>(F.lds, pg8::Gemm{DM, DM, DM}, S, E, F.tid);
                SEAM(PH_QKV0 + 3 * hb);
            }
            if (IN(PH_ATT0 + 3 * hb)) { FRAME(); att::attn_phase(F.lds, (const bf16_t*)(ws + WS_QKVB), (bf16_t*)(ws + WS_OPART), (float*)(ws + WS_LSE), (bf16_t*)(ws + WS_HB) + (size_t)hb * HTOK * DM, bar, F.G, (int)blockIdx.x, F.tid); SEAM(PH_ATT0 + 3 * hb); }
        }
        if (IN(PH_WO)) { FRAME();
            pg8::SchedPlain S; S.tm.init(NTOK / 256, DM / 256, F.G, (int)blockIdx.x); S.A = (const char*)(ws + WS_HB); S.Bt = (const char*)(ws + WS_WO) + (size_t)lp * DM * DM * 2; S.atile = 256 * DM * 2; S.btile = 256 * DM * 2;
            pg8::EpiResB<false, true> E{XB, nullptr, (float*)(ws + WS_SSP)};
            pg8::gemm_phase<pg8::EpiResB<false, true>, pg8::SchedPlain, true, true>(F.lds, pg8::Gemm{DM, DM, DM}, S, E, F.tid);
            SEAM(PH_WO);
        }
        if (IN(PH_RINV)) { FRAME(); rinv_pass(F); SEAM(PH_RINV); }
        if (IN(PH_DGU)) { FRAME();
            pg8::SchedPlain S; S.tm.init(NTOK / 256, 2 * DFF / 256, F.G, (int)blockIdx.x); S.A = (const char*)XB; S.Bt = (const char*)(ws + WS_WDGU) + (size_t)lp * 2 * DFF * DM * 2; S.atile = 256 * DM * 2; S.btile = 256 * DM * 2;
            pg8::EpiGU<1> E{(bf16_t*)(ws + WS_ACT), DFF, (const float*)(ws + WS_RINV)};
            pg8::gemm_phase<pg8::EpiGU<1>, pg8::SchedPlain, true, true>(F.lds, pg8::Gemm{DM, DM, DM}, S, E, F.tid);
            SEAM(PH_DGU);
        }
        if (IN(PH_DDOWN)) { FRAME();
            pg8::SchedPlain S; S.tm.init(NTOK / 256, DM / 256, F.G, (int)blockIdx.x); S.A = (const char*)(ws + WS_ACT); S.Bt = (const char*)(ws + WS_WDD) + (size_t)lp * DM * DFF * 2; S.atile = (size_t)256 * DFF * 2; S.btile = (size_t)256 * DFF * 2;
            pg8::EpiResB<false, true> E{XB, nullptr, (float*)(ws + WS_SSP2)};
            pg8::gemm_phase<pg8::EpiResB<false, true>, pg8::SchedPlain, true, true>(F.lds, pg8::Gemm{DFF, DFF, DFF}, S, E, F.tid);
            SEAM(PH_DDOWN);
        }
        if (IN(PH_PPREP)) { FRAME(); pool_prep(F, F.mix_norm + (size_t)(2 * lp + 1) * DM); SEAM(PH_PPREP); }
        if (IN(PH_PGEMM)) { FRAME();
            pg8::SchedPool S; S.tm.init(NTOK / 256, 4, F.G, (int)blockIdx.x); S.A = (const char*)(ws + WS_HB); S.Bt = (const char*)(ws + WS_WPOOL) + (size_t)lp * 4 * 65536 * 2; S.atile = 256 * DM * 2;
            pg8::EpiResB<true, false> E{XB, F.pool_scale + (size_t)lp * DM, nullptr};
            pg8::gemm_phase<pg8::EpiResB<true, false>, pg8::SchedPool, true, true>(F.lds, pg8::Gemm{256, DM, 256}, S, E, F.tid);
            SEAM(PH_PGEMM);
        }
        if (IN(PH_ROUTE)) { FRAME(); router_pass(F, lp, F.ffn_norm + (size_t)(2 * lp + 1) * DM, F.router + (size_t)lp * DM * 8); SEAM(PH_ROUTE); }
        if (IN(PH_RLIST)) { FRAME(); router_lists(F, lp); SEAM(PH_RLIST); }
        if (IN(PH_MGU)) { FRAME();
            pg8::SchedMoe S; S.pt = (const LAS int*)(F.lds + MISC_OFF) + 16; S.toks = (const int*)(ws + WS_LISTS); const int ntile = expert_tiles_lds(F, lp); S.tm.init(ntile, 2 * DFFE / 256, F.G, (int)blockIdx.x);
            S.A = (const char*)XB; S.Bt = (const char*)(ws + WS_WMGU); S.atile = 0; S.btile = 256 * DM * 2; S.estride = (size_t)2 * DFFE * DM * 2;
            pg8::EpiGU<2> E{(bf16_t*)(ws + WS_ACT2), DFFE, (const float*)(ws + WS_LISTS + 2 * MiB)};
            pg8::gemm_phase<pg8::EpiGU<2>, pg8::SchedMoe, true, true, true>(F.lds, pg8::Gemm{DM, DM, DM}, S, E, F.tid);
            SEAM(PH_MGU);
        }
        if (IN(PH_MDOWN)) { FRAME();
            pg8::SchedMoe S; S.pt = (const LAS int*)(F.lds + MISC_OFF) + 16; S.toks = nullptr; const int ntile = expert_tiles_lds(F, lp); S.tm.init(ntile, DM / 256, F.G, (int)blockIdx.x);
            const int full = (ntile * 4) / F.G; S.tm.maxi = full;
            S.A = (const char*)(ws + WS_ACT2); S.Bt = (const char*)(ws + WS_WMD); S.atile = (size_t)256 * DFFE * 2; S.btile = (size_t)256 * DFFE * 2; S.estride = (size_t)DM * DFFE * 2;
            pg8::EpiMoeDown E{(bf16_t*)(ws + WS_Y), (const float*)(ws + WS_LISTS + MiB), (const int*)(ws + WS_LISTS + 3 * MiB)};
            pg8::gemm_phase<pg8::EpiMoeDown, pg8::SchedMoe, true, true>(F.lds, pg8::Gemm{DFFE, DFFE, DFFE}, S, E, F.tid);
            pg8::SchedMoeSplit S2; S2.tm = S.tm; S2.tm.maxi = 0x7fffffff; S2.A = S.A; S2.Bt = S.Bt; S2.atile = S.atile; S2.btile = S.btile; S2.estride = S.estride; S2.pt = S.pt; S2.first = full * F.G; S2.nsplit = ntile * 4 - full * F.G;
            pg8::EpiPart E2{(float*)(ws + WS_PART)};
            pg8::gemm_phase<pg8::EpiPart, pg8::SchedMoeSplit, true, true>(F.lds, pg8::Gemm{DFFE / 4, DFFE, DFFE}, S2, E2, F.tid);
            SEAM(PH_MDOWN);
        }
        if (IN(PH_MFIX)) { FRAME();
            const int ntile = expert_tiles_lds(F, lp); pg8::TileMap tm; tm.init(ntile, DM / 256, F.G, (int)blockIdx.x); const int full = (ntile * 4) / F.G;
            moe_fixup(F, tm, full * F.G, ntile * 4 - full * F.G);
            SEAM(PH_MFIX);
        }
        if (IN(PH_COMB)) { FRAME();
            if (lp == 0) { combine_pass(F, lp, nullptr, false); convert_moe(F, 1); SEAM(PH_COMB); }
            else { combine_pass(F, lp, F.final_norm, true); SEAM(PH_COMB); }
        }
#undef PHID
#undef IN
#undef SEAM
    }
}
#if DEBUG_CHECK
namespace dbg {
__device__ __forceinline__ unsigned hsh(unsigned a) { a ^= a >> 16; a *= 0x7feb352dU; a ^= a >> 15; a *= 0x846ca68bU; a ^= a >> 16; return a; }
__device__ __forceinline__ void report(unsigned* d, int id, float err, float tol) { float ratio = err / tol; if (!(ratio <= 1.f)) { if (!(ratio < 1e30f)) ratio = 1e30f; atomicMax(d + id, __float_as_uint(ratio)); } }
__device__ __forceinline__ float silu(float g) { return g / (1.0f + expf(-g)); }
__device__ __forceinline__ void wdot(const bf16_t* a, const float* w, size_t ldw, int K, const float* gain, int lane, float& dot, float& ad) {
    float s = 0.f, t = 0.f; for (int k = lane; k < K; k += 64) { const float p = bf2f(a[k]) * w[(size_t)k * ldw] * (gain ? gain[k] : 1.f); s += p; t += fabsf(p); } dot = wave_sum(s); ad = wave_sum(t); }
__device__ __forceinline__ float row_r(const float* xrow, int lane) { float s = 0.f; for (int k = lane; k < DM; k += 64) s += xrow[k] * xrow[k]; return 1.0f / sqrtf(wave_sum(s) * (1.0f / DM) + RMS_EPS); }
__device__ __forceinline__ float row_rb(const bf16_t* xrow, int lane) { float s = 0.f; for (int k = lane; k < DM; k += 64) { const float v = bf2f(xrow[k]); s += v * v; } return 1.0f / sqrtf(wave_sum(s) * (1.0f / DM) + RMS_EPS); }
__device__ __forceinline__ void tiles(const unsigned* cnt, int (&pt)[9]) { int acc = 0; for (int q = 0; q < 8; ++q) { pt[q] = acc; acc += ((int)cnt[q] + 255) >> 8; } pt[8] = acc; }

__global__ void snap_pos(const bf16_t* src, float* snap, unsigned salt) { const unsigned k = blockIdx.x * 64 + threadIdx.x; const unsigned h = hsh(k * 2654435761u + salt); snap[k] = bf2f(src[(size_t)(h % NTOK) * DM + (hsh(h) % DM)]); }
__global__ void snap_rows(const bf16_t* src, float* snap, unsigned salt) { const unsigned k = blockIdx.x; const unsigned row = hsh(k * 2654435761u + salt) % NTOK; for (int c = threadIdx.x; c < DM; c += 64) snap[(size_t)k * DM + c] = bf2f(src[(size_t)row * DM + c]); }

__global__ void chk_cast(const float* x, const bf16_t* xb, const float* rq, unsigned* d, int id) {
    const int lane = threadIdx.x; const unsigned row = hsh(blockIdx.x * 2654435761u + 11u) % NTOK; const float r = row_r(x + (size_t)row * DM, lane); float e = 0.f;
    for (int c = lane; c < DM; c += 64) { const float ref = x[(size_t)row * DM + c]; e = fmaxf(e, fabsf(bf2f(xb[(size_t)row * DM + c]) - ref) / (0.005f * fabsf(ref) + 1e-6f)); }
    e = fmaxf(wave_max(e), fabsf(rq[row] - r) / (1e-4f * r)); if (lane == 0) report(d, id, e, 1.f);
}
__global__ void chk_qkv(const bf16_t* xbh, const float* rqh, const float* w, const float* gain, const bf16_t* qkvb, unsigned* d, int id) {
    const int lane = threadIdx.x; const unsigned hh = hsh(blockIdx.x * 2654435761u + 23u); const int row = hh % HTOK, c = hsh(hh) % NQKV;
    const int g = c / 3072, t = (c % 3072) >> 10, h = (c & 1023) >> 6, dd = c & 63, dsh = 2 * g, Lg = SEQ >> dsh;
    const int s = row & 2047, bl = row >> 11, r = s & ((1 << dsh) - 1), j = s >> dsh, seq = ((bl << dsh) + r) * NHEAD + h; const float rf = rqh[row];
    float ref, tol; int pos;
    if (t < 2) { const int dlo = dd & 31, cb = c - dd; float tlo, thi, a0, a1; wdot(xbh + (size_t)row * DM, w + cb + dlo, NQKV, DM, gain, lane, tlo, a0); wdot(xbh + (size_t)row * DM, w + cb + dlo + 32, NQKV, DM, gain, lane, thi, a1);
        tlo *= rf; thi *= rf; a0 *= rf; a1 *= rf;
        const float ang = (float)s * powf(10000.0f, -(float)(2 * dlo) / 64.0f), cs = cosf(ang), sn = sinf(ang); const float olo = tlo * cs - thi * sn, ohi = thi * cs + tlo * sn;
        ref = dd < 32 ? olo : ohi; tol = 0.01f * (a0 + a1) + 2e-3f; if (t == 0) { ref *= QSCALE; tol *= QSCALE; tol += 1e-3f; } pos = dd < 32 ? 2 * dlo : 2 * dlo + 1; }
    else { float a0; wdot(xbh + (size_t)row * DM, w + c, NQKV, DM, gain, lane, ref, a0); ref *= rf; tol = 0.01f * a0 * rf + 2e-3f; pos = dd; }
    const float got = bf2f(qkvb[(size_t)(g * 3 + t) * ((size_t)HTOK * DM) + ((size_t)seq * Lg + j) * HDIM + pos]);
    if (lane == 0) report(d, id, fabsf(got - ref), tol);
}
__device__ float attn_ref(const bf16_t* qkvb, int g, int seq, int j, int lane, float& lref) {
    const int dsh = 2 * g, Lg = SEQ >> dsh;
    const size_t GS = (size_t)HTOK * DM; const bf16_t* qb = qkvb + (size_t)(g * 3) * GS + ((size_t)seq * Lg) * HDIM; const bf16_t* kb = qb + GS; const bf16_t* vb = kb + GS;
    float sc[3]; float mx = -1e30f;
    for (int i = 0; i < 3; ++i) { const int kk = lane + 64 * i, jk = j - 128 + kk; sc[i] = -1e30f;
        if (kk <= 128 && jk >= 0) { float s = 0.f; for (int e = 0; e < 64; ++e) s += bf2f(qb[(size_t)j * 64 + e]) * bf2f(kb[(size_t)jk * 64 + e]); sc[i] = s; } mx = fmaxf(mx, sc[i]); }
    mx = wave_max(mx); float l = 0.f, p[3];
    for (int i = 0; i < 3; ++i) { p[i] = sc[i] > -1e29f ? exp2f(sc[i] - mx) : 0.f; l += p[i]; }
    l = wave_sum(l); float mine = 0.f;
    for (int dd = 0; dd < 64; ++dd) { float o = 0.f; for (int i = 0; i < 3; ++i) { const int kk = lane + 64 * i, jk = j - 128 + kk; if (p[i] > 0.f) o += p[i] * bf2f(vb[(size_t)jk * 64 + dd]); }
        o = wave_sum(o) / l; if (dd == lane) mine = o; }
    lref = mx + log2f(l); return mine;
}
__global__ void chk_attn(const bf16_t* qkvb, const bf16_t* opart, const float* lse, const bf16_t* hbh, unsigned* d, int id) {
    const int lane = threadIdx.x; const unsigned hh = hsh(blockIdx.x * 2654435761u + 37u); const int g = blockIdx.x % 3; float e = 0.f;
    if (g < 2) { const int dsh = 2 * g, Lg = SEQ >> dsh, nseq = (HTOK * NHEAD) / Lg;
        const int seq = hh % nseq; int j = hsh(hh) % Lg; if ((blockIdx.x / 3) % 4 == 0) j = j % 130;
        const int h = seq & 15, br = seq >> 4, bl = br >> dsh, r = br & ((1 << dsh) - 1); const size_t tokrow = (size_t)bl * SEQ + ((size_t)j << dsh) + r;
        float lref; const float o = attn_ref(qkvb, g, seq, j, lane, lref);
        const float got = bf2f(opart[(size_t)g * ((size_t)HTOK * DM) + tokrow * DM + h * 64 + lane]); e = fabsf(got - o) / (0.02f * fabsf(o) + 0.02f);
        const float lgot = lse[(size_t)g * ((size_t)HTOK * NHEAD) + tokrow * NHEAD + h]; e = fmaxf(e, fabsf(lref - lgot) / 0.02f); }
    else { int row = hh % HTOK; if ((blockIdx.x / 3) % 4 == 0) row = (row & ~(SEQ - 1)) + (row & 511); const int h = hsh(hh) % NHEAD, bl = row / SEQ, s = row % SEQ;
        float o[3], l[3], mx = -1e30f, sum = 0.f, m = 0.f;
        for (int gg = 0; gg < 3; ++gg) { const int dsh = 2 * gg, r = s & ((1 << dsh) - 1), j = s >> dsh, seq = ((bl << dsh) + r) * 16 + h; o[gg] = attn_ref(qkvb, gg, seq, j, lane, l[gg]); mx = fmaxf(mx, l[gg]); }
        for (int gg = 0; gg < 3; ++gg) sum += exp2f(l[gg] - mx);
        for (int gg = 0; gg < 3; ++gg) m += exp2f(l[gg] - mx) / sum * o[gg];
        e = fabsf(bf2f(hbh[(size_t)row * DM + h * 64 + lane]) - m) / (0.02f * fabsf(m) + 0.02f); }
    e = wave_max(e); if (lane == 0) report(d, id, e, 1.f);
}
__global__ void chk_merge(const bf16_t* opart, const float* lse, const bf16_t* hbh, unsigned* d, int id) {
    const int lane = threadIdx.x; const unsigned hh = hsh(blockIdx.x * 2654435761u + 41u); const int row = hh % HTOK; float e = 0.f;
    for (int c = lane; c < DM; c += 64) { const int h = c >> 6; float l[3], w[3], mx = -1e30f, sum = 0.f, o = 0.f;
        for (int g = 0; g < 3; ++g) { l[g] = lse[(size_t)g * ((size_t)HTOK * NHEAD) + (size_t)row * NHEAD + h]; mx = fmaxf(mx, l[g]); }
        for (int g = 0; g < 3; ++g) { w[g] = exp2f(l[g] - mx); sum += w[g]; }
        for (int g = 0; g < 3; ++g) o += w[g] / sum * bf2f(opart[(size_t)g * ((size_t)HTOK * DM) + (size_t)row * DM + c]);
        e = fmaxf(e, fabsf(bf2f(hbh[(size_t)row * DM + c]) - o) / (0.01f * fabsf(o) + 5e-3f)); }
    e = wave_max(e); if (lane == 0) report(d, id, e, 1.f);
}
__global__ void chk_res(const bf16_t* xb, const float* snap, unsigned salt, const bf16_t* A, int lda, int K, const float* W, int ldw, int wsel, const float* scale, unsigned* d, int id) {
    const int lane = threadIdx.x; const unsigned k = blockIdx.x; const unsigned h = hsh(k * 2654435761u + salt); const int row = h % NTOK, col = hsh(h) % DM;
    float dot, ad; if (wsel == 0) wdot(A + (size_t)row * lda, W + col, ldw, K, nullptr, lane, dot, ad); else wdot(A + (size_t)row * lda + (col & ~255), W + (size_t)(col >> 8) * 65536 + (col & 255), 256, 256, nullptr, lane, dot, ad);
    const float sc = scale ? scale[col] : 1.f; const float ref = snap[k] + sc * dot, got = bf2f(xb[(size_t)row * DM + col]);
    if (lane == 0) report(d, id, fabsf(got - ref), 0.01f * fabsf(sc) * ad + 0.005f * fabsf(ref) + 2e-3f);
}
__global__ void chk_ssp(const bf16_t* xb, const float* ssp, unsigned* d, int id) {
    const int lane = threadIdx.x; const unsigned row = hsh(blockIdx.x * 2654435761u + 59u) % NTOK; float s = 0.f;
    for (int c = lane; c < DM; c += 64) { const float v = bf2f(xb[(size_t)row * DM + c]); s += v * v; }
    s = wave_sum(s); float sp = 0.f; if (lane < 16) sp = ssp[(size_t)lane * NTOK + row]; sp = wave_sum(sp);
    if (lane == 0) report(d, id, fabsf(sp - s), 5e-3f * s + 1e-6f);
}
__global__ void chk_gu(const bf16_t* xb, const float* gain, const float* wg, const float* wu, int nff, const bf16_t* act, const unsigned char* rt, const unsigned* cnt, size_t estride, unsigned* d, int id) {
    const int lane = threadIdx.x; const unsigned hh = hsh(blockIdx.x * 2654435761u + 61u); const int token = hh % NTOK; const int j = hsh(hh) % nff; size_t eo = 0; int dest = token;
    const float r = row_rb(xb + (size_t)token * DM, lane);
    if (rt) { const int k = (hh >> 20) & 1; const int ee = ((const int*)(rt + RT_E))[2 * token + k]; int pt[9]; tiles(cnt, pt); eo = (size_t)ee * estride; dest = pt[ee] * 256 + ((const int*)(rt + RT_RANK))[2 * token + k]; }
    float g, u, a0, a1; wdot(xb + (size_t)token * DM, wg + eo + j, nff, DM, gain, lane, g, a0); wdot(xb + (size_t)token * DM, wu + eo + j, nff, DM, gain, lane, u, a1);
    const float ref = silu(g * r) * (u * r), got = bf2f(act[(size_t)dest * nff + j]);
    if (lane == 0) report(d, id, fabsf(got - ref), 0.02f * fabsf(ref) + 0.01f * r * r * (a0 * fabsf(u) + a1 * fabsf(g)) + 5e-3f);
}
__global__ void chk_pprep(const bf16_t* xb, const float* gain, const bf16_t* pa, unsigned* d, int id) {
    const int lane = threadIdx.x; const unsigned hh = hsh(blockIdx.x * 2654435761u + 67u); int row = hh % NTOK; const int c = hsh(hh) % DM; if (blockIdx.x % 4 == 0) row = (row & ~2047) + (row & 15);
    const int t = row & 2047, g = c >> 8, P = 2 << g, lo = (t + 1 - P) > 0 ? (t + 1 - P) : 0; float sum = 0.f, cur = 0.f;
    for (int tt = lo; tt <= t; ++tt) { const bf16_t* xr = xb + (size_t)(row - t + tt) * DM; const float hn = bf2f(xr[c]) * row_rb(xr, lane) * gain[c]; sum += hn; cur = hn; }
    const float ref = sum / (float)(t + 1 - lo) - cur, got = bf2f(pa[(size_t)row * DM + c]);
    if (lane == 0) report(d, id, fabsf(got - ref), 0.01f * fabsf(ref) + 0.01f * fabsf(cur) + 2e-3f);
}
__global__ void chk_route(const bf16_t* xb, const float* gain, const float* wr, const unsigned char* rt, const unsigned* cnt, const int* ltok, const float* lgate, const float* lr, unsigned* d, int id) {
    const int lane = threadIdx.x; const unsigned token = hsh(blockIdx.x * 2654435761u + 71u) % NTOK; const bf16_t* xr = xb + (size_t)token * DM; const float r = row_rb(xr, lane);
    float lg[8]; for (int e = 0; e < 8; ++e) { float s = 0.f; for (int c = lane; c < DM; c += 64) s += bf2f(xr[c]) * r * gain[c] * wr[(size_t)c * 8 + e]; lg[e] = wave_sum(s); }
    int i0 = 0; for (int e = 1; e < 8; ++e) if (lg[e] > lg[i0]) i0 = e; int i1 = -1; for (int e = 0; e < 8; ++e) if (e != i0 && (i1 < 0 || lg[e] > lg[i1])) i1 = e;
    float third = -1e30f; for (int e = 0; e < 8; ++e) if (e != i0 && e != i1) third = fmaxf(third, lg[e]);
    const int* re = (const int*)(rt + RT_E); const int* rk = (const int*)(rt + RT_RANK); const float* rg = (const float*)(rt + RT_GATE);
    float e = 0.f; const bool clear = (lg[i0] - lg[i1] > 1e-3f) && (lg[i1] - third > 1e-3f);
    if (clear) { if (re[2 * token] != i0 || re[2 * token + 1] != i1) e = 1e6f; const float g0 = 1.0f / (1.0f + expf(lg[i1] - lg[i0])); e = fmaxf(e, fabsf(rg[2 * token] - g0) / 2e-3f); e = fmaxf(e, fabsf(rg[2 * token + 1] - (1.f - g0)) / 2e-3f); }
    for (int k = 0; k < 2; ++k) { const int ee = re[2 * token + k], rank = rk[2 * token + k]; if (ee < 0 || ee > 7 || rank < 0 || rank >= (int)cnt[ee]) { e = 2e6f; continue; }
        const size_t li = (size_t)ee * NTOK + rank; if (ltok[li] != (int)token) e = fmaxf(e, 3e6f); if (fabsf(lgate[li] - rg[2 * token + k]) > 1e-6f) e = fmaxf(e, 4e6f); e = fmaxf(e, fabsf(lr[li] - r) / (1e-4f * r)); }
    if (lane == 0) report(d, id, e, 1.f);
}
__global__ void chk_mdown(const bf16_t* act2, const float* md, const bf16_t* y, const unsigned char* rt, const unsigned* cnt, unsigned* d, int id) {
    const int lane = threadIdx.x; const unsigned hh = hsh(blockIdx.x * 2654435761u + 73u); const int token = hh % NTOK, col = hsh(hh) % DM, k = (hh >> 20) & 1;
    int pt[9]; tiles(cnt, pt); const int ee = ((const int*)(rt + RT_E))[2 * token + k], ds = pt[ee] * 256 + ((const int*)(rt + RT_RANK))[2 * token + k]; const float gt = ((const float*)(rt + RT_GATE))[2 * token + k];
    float dot, ad; wdot(act2 + (size_t)ds * DFFE, md + (size_t)ee * DFFE * DM + col, DM, DFFE, nullptr, lane, dot, ad);
    if (lane == 0) report(d, id, fabsf(bf2f(y[(size_t)(2 * token + k) * DM + col]) - gt * dot), 0.01f * gt * ad + 0.01f * fabsf(gt * dot) + 2e-3f);
}
__global__ void chk_comb(const float* out, const bf16_t* xb, const float* rq, const float* snaprows, unsigned salt, const bf16_t* y, const unsigned char* rt, const unsigned* cnt, const float* gain, int last, unsigned* d, int id) {
    const int lane = threadIdx.x; const unsigned k = blockIdx.x; const unsigned token = hsh(k * 2654435761u + salt) % NTOK; (void)cnt; (void)rt;
    const int d0 = 2 * token, d1 = 2 * token + 1; float s = 0.f;
    for (int c = lane; c < DM; c += 64) { const float v = snaprows[(size_t)k * DM + c] + bf2f(y[(size_t)d0 * DM + c]) + bf2f(y[(size_t)d1 * DM + c]); s += v * v; }
    const float r = 1.0f / sqrtf(wave_sum(s) * (1.0f / DM) + RMS_EPS); float e = 0.f;
    for (int c = lane; c < DM; c += 64) { const float v = snaprows[(size_t)k * DM + c] + bf2f(y[(size_t)d0 * DM + c]) + bf2f(y[(size_t)d1 * DM + c]);
        if (last) { const float n = v * r * gain[c]; e = fmaxf(e, fabsf(out[(size_t)token * DM + c] - n) / (1e-3f * fabsf(n) + 1e-4f)); }
        else e = fmaxf(e, fabsf(bf2f(xb[(size_t)token * DM + c]) - v) / (0.005f * fabsf(v) + 1e-5f)); }
    e = wave_max(e); if (!last) e = fmaxf(e, fabsf(rq[token] - r) / (1e-3f * r)); if (lane == 0) report(d, id, e, 1.f);
}
__global__ void report_out(float* out, int n, const unsigned* d, const unsigned* tmo) {
    int id = -1; for (int k = 0; k < 64; ++k) if (d[k] != 0u) { id = k; break; }
    if (id < 0 && tmo[XB_TMO] != 0u) id = 63;
    if (id < 0) return;
    const float c = sqrtf(1.01f * (float)(10 + id)) * 10.f;
    for (int i = blockIdx.x * blockDim.x + threadIdx.x; i < n; i += gridDim.x * blockDim.x) out[i] = c;
}
}
#endif

#if PROBE
#ifndef PROBE_SC
#define PROBE_SC 10.0f
#define PROBE_OFF 10.0f
#endif
__global__ void probe_out(float* out, const unsigned long long* ts, unsigned long long maskA, unsigned long long maskB) {
    float d1 = 0.f, d2 = 0.f;
#ifdef PROBE_SEG
    d1 = (float)ts[64 + PROBE_SEG] * 0.01f;
#else
    for (int k = 0; k < 2 * NPH; ++k) { if (k == NPH) continue; const unsigned long long t1 = ts[k + 1], t0 = (k == NPH + 1) ? ts[NPH] : ts[k]; const float us = (float)(t1 - t0) * 0.01f;     if ((maskA >> k) & 1ull) d1 += us; if ((maskB >> k) & 1ull) d2 += us; }
#endif
    const float V = PROBE_SC * logf(fmaxf(d1, 3.f)) - PROBE_OFF;
    if (blockIdx.x == 0 && threadIdx.x == 0) out[(size_t)NTOK * DM - 1] = V + 0.f * d2;
}
#ifndef PROBE_A
#define PROBE_A 1ull
#endif
#ifndef PROBE_SC
#define PROBE_SC 10.0f
#define PROBE_OFF 10.0f
#endif
#ifndef PROBE_B
#define PROBE_B 1ull
#endif
#endif
extern "C" void kernel_launch(void* const* d_in, const int* in_sizes, int n_in, void* d_out, int out_size, void* d_ws, size_t ws_size, hipStream_t stream) {
    static int grid = 0;
    if (grid == 0) {
        if (n_in != 15 || out_size != NTOK * DM || ws_size < WS_END + (DEBUG_CHECK ? 4 * MiB : 0)) { fprintf(stderr, "kernel_launch: unexpected shapes / workspace (%d inputs, out %d, ws %zu)\n", n_in, out_size, ws_size); grid = -1; return; }
        int dev = 0, cus = 0, per_cu = 0;
        if (hipGetDevice(&dev) != hipSuccess || hipDeviceGetAttribute(&cus, hipDeviceAttributeMultiprocessorCount, dev) != hipSuccess) { grid = -1; return; }
        if (hipFuncSetAttribute((const void*)fwd, hipFuncAttributeMaxDynamicSharedMemorySize, LDS_BYTES) != hipSuccess) { grid = -1; return; }
        if (hipOccupancyMaxActiveBlocksPerMultiprocessor(&per_cu, (const void*)fwd, 512, LDS_BYTES) != hipSuccess || per_cu < 1) fprintf(stderr, "kernel_launch: occupancy query reports %d\n", per_cu);
        (void)hipGetLastError();
        grid = cus;
    }
    if (grid < 0) return;
    (void)hipMemsetAsync((char*)d_ws + WS_CTL, 0, CTL_ZERO_BYTES, stream);
    Args a{};
    for (int i = 0; i < 15; ++i) a.in[i] = (const float*)d_in[i];
    a.out = (float*)d_out; a.ws = (unsigned char*)d_ws;
#if !DEBUG_CHECK
    a.ph_lo = 0; a.ph_hi = 2 * NPH; a.li = 0; a.pad = 0;
    hipLaunchKernelGGL(fwd, dim3(grid), dim3(512), LDS_BYTES, stream, a);
#if TWICE
    (void)hipMemsetAsync((char*)d_ws + WS_CTL, 0, CTL_ZERO_BYTES, stream);
    hipLaunchKernelGGL(fwd, dim3(grid), dim3(512), LDS_BYTES, stream, a);
#endif
#if PROBE
    probe_out<<<256, 256, 0, stream>>>((float*)d_out, (const unsigned long long*)((unsigned char*)d_ws + WS_SNAP), PROBE_A, PROBE_B);
#endif
#else
    unsigned char* ws = (unsigned char*)d_ws; unsigned* ctl = (unsigned*)ws; unsigned* D = ctl + CW_DBG; float* xo = (float*)d_out;
    float* snap = (float*)(ws + WS_SNAP); float* snaprows = (float*)(ws + WS_SNAP + 1 * MiB);
    const float* const* in = (const float* const*)d_in; unsigned char* rt = ws + WS_RT;
    const bf16_t* XB = (const bf16_t*)(ws + WS_XB); const bf16_t* HB = (const bf16_t*)(ws + WS_HB); const float* RQ = (const float*)(ws + WS_RINV) + NTOK;
    constexpr int NS = 256;
    for (int ph = 0; ph < 2 * NPH; ++ph) {
        const int lp = ph / NPH, k = ph % NPH; if (lp == 1 && k == PH_PRE) continue;
        const int cid = 20 * lp; const unsigned salt = 1000u + ph; const unsigned* cnt = ctl + CW_CNT + 64 * lp;
        if (k == PH_WO || k == PH_DDOWN || k == PH_PGEMM) dbg::snap_pos<<<NS / 64, 64, 0, stream>>>(XB, snap, salt);
        if (k == PH_COMB) dbg::snap_rows<<<64, 64, 0, stream>>>(XB, snaprows, salt);
        a.ph_lo = ph; a.ph_hi = ph + 1; a.li = ph; a.pad = 0;
        hipLaunchKernelGGL(fwd, dim3(grid), dim3(512), LDS_BYTES, stream, a);
        if (k == PH_PRE) dbg::chk_cast<<<64, 64, 0, stream>>>(in[0], XB, RQ, D, 1);
        if (k == PH_QKV0 || k == PH_QKV1) { const size_t ho = (size_t)(k == PH_QKV1) * HTOK; dbg::chk_qkv<<<NS, 64, 0, stream>>>(XB + ho * DM, RQ + ho, in[3] + (size_t)lp * DM * NQKV, in[1] + (size_t)(2 * lp) * DM, (const bf16_t*)(ws + WS_QKVB), D, cid + (k == PH_QKV0 ? 2 : 3)); }
        if (k == PH_ATT0 || k == PH_ATT1) dbg::chk_attn<<<NS * 3, 64, 0, stream>>>((const bf16_t*)(ws + WS_QKVB), (const bf16_t*)(ws + WS_OPART), (const float*)(ws + WS_LSE), HB + (size_t)(k == PH_ATT1) * HTOK * DM, D, cid + 4);
        if (false) dbg::chk_merge<<<64, 64, 0, stream>>>((const bf16_t*)(ws + WS_OPART), (const float*)(ws + WS_LSE), HB + (size_t)(k == PH_MRG1) * HTOK * DM, D, cid + 5);
        if (k == PH_WO) { dbg::chk_res<<<NS, 64, 0, stream>>>(XB, snap, salt, HB, DM, DM, in[4] + (size_t)lp * DM * DM, DM, 0, nullptr, D, cid + 6);
            dbg::chk_ssp<<<64, 64, 0, stream>>>(XB, (const float*)(ws + WS_SSP), D, cid + 6); }
        if (k == PH_DGU) dbg::chk_gu<<<NS, 64, 0, stream>>>(XB, in[2] + (size_t)(2 * lp) * DM, in[7] + (size_t)lp * DM * DFF, in[8] + (size_t)lp * DM * DFF, DFF, (const bf16_t*)(ws + WS_ACT), nullptr, nullptr, 0, D, cid + 7);
        if (k == PH_DDOWN) { dbg::chk_res<<<NS, 64, 0, stream>>>(XB, snap, salt, (const bf16_t*)(ws + WS_ACT), DFF, DFF, in[9] + (size_t)lp * DFF * DM, DM, 0, nullptr, D, cid + 8);
            dbg::chk_ssp<<<64, 64, 0, stream>>>(XB, (const float*)(ws + WS_SSP2), D, cid + 8); }
        if (k == PH_PPREP) dbg::chk_pprep<<<NS, 64, 0, stream>>>(XB, in[1] + (size_t)(2 * lp + 1) * DM, HB, D, cid + 9);
        if (k == PH_PGEMM) dbg::chk_res<<<NS, 64, 0, stream>>>(XB, snap, salt, HB, DM, 256, in[5] + (size_t)lp * 4 * 65536, 256, 1, in[6] + (size_t)lp * DM, D, cid + 10);
        if (k == PH_RLIST) dbg::chk_route<<<NS, 64, 0, stream>>>(XB, in[2] + (size_t)(2 * lp + 1) * DM, in[10] + (size_t)lp * DM * 8, rt, cnt, (const int*)(ws + WS_LISTS), (const float*)(ws + WS_LISTS + MiB), (const float*)(ws + WS_LISTS + 2 * MiB), D, cid + 11);
        if (k == PH_MGU) dbg::chk_gu<<<NS, 64, 0, stream>>>(XB, in[2] + (size_t)(2 * lp + 1) * DM, in[11] + (size_t)lp * 8 * DM * DFFE, in[12] + (size_t)lp * 8 * DM * DFFE, DFFE, (const bf16_t*)(ws + WS_ACT2), rt, cnt, (size_t)DM * DFFE, D, cid + 12);
        if (k == PH_MFIX) dbg::chk_mdown<<<NS, 64, 0, stream>>>((const bf16_t*)(ws + WS_ACT2), in[13] + (size_t)lp * 8 * DFFE * DM, (const bf16_t*)(ws + WS_Y), rt, cnt, D, cid + 13);
        if (k == PH_COMB) dbg::chk_comb<<<64, 64, 0, stream>>>(xo, XB, RQ, snaprows, salt, (const bf16_t*)(ws + WS_Y), rt, cnt, in[14], lp == 1, D, cid + 14);
    }
    dbg::report_out<<<1024, 256, 0, stream>>>(xo, out_size, D, ctl + CW_BAR);
#endif
}
```
